# Optimizing an MI355X kernel written in HIP

```python
import jax, jax.numpy as jnp
from jax import lax
import numpy as np

D_MODEL = 1024
BATCH = 1
SEQ = 16384
DEPTH = 1

N_META = 16
EPS = 1e-6
ATT_HEADS = 8
Q_LORA = 384
KV_LORA = 256
QK_NOPE = 128
QK_ROPE = 64
V_HEAD = 128
ROPE_THETA = 10000.0
ATT_WIDTH = ATT_HEADS * V_HEAD
Q_BLOCK = 128
SSM_HEADS = 16
SSM_HEAD_DIM = 64
SSM_WIDTH = SSM_HEADS * SSM_HEAD_DIM
SSM_GROUPS = 2
SSM_HEADS_PER_GROUP = SSM_HEADS // SSM_GROUPS
SSM_STATE = 128
CONV_K = 4
CHUNK = 128
CONV_DIM = SSM_WIDTH + 2 * SSM_GROUPS * SSM_STATE
MIX_WIDTH = ATT_WIDTH + SSM_WIDTH
D_FF = 4 * D_MODEL
IN_SPLITS = (Q_LORA, KV_LORA, QK_ROPE, SSM_WIDTH, CONV_DIM, SSM_HEADS)
IN_WIDTH = sum(IN_SPLITS)
IN_OFFSETS = tuple(int(v) for v in np.cumsum(IN_SPLITS)[:-1])

kernel_name = "hymba_mla_ssd_sandwich_layer"


def rmsnorm(x, w):
    x32 = x.astype(jnp.float32)
    y = x32 * lax.rsqrt(jnp.mean(jnp.square(x32), axis=-1, keepdims=True) + EPS)
    return y.astype(x.dtype) * w


def gated_group_rmsnorm(y, z, w):
    g = (y * jax.nn.silu(z)).astype(jnp.float32)
    shp = g.shape
    g = g.reshape(*shp[:-1], SSM_GROUPS, shp[-1] // SSM_GROUPS)
    g = g * lax.rsqrt(jnp.mean(jnp.square(g), axis=-1, keepdims=True) + EPS)
    return g.reshape(shp).astype(z.dtype) * w


def rope_tables(length, dtype):
    inv_freq = ROPE_THETA ** (-jnp.arange(0, QK_ROPE, 2, dtype=jnp.float32) / QK_ROPE)
    ang = jnp.arange(length, dtype=jnp.float32)[:, None] * inv_freq[None, :]
    return jnp.cos(ang).astype(dtype), jnp.sin(ang).astype(dtype)


def apply_rope(x, cos, sin):
    x1, x2 = jnp.split(x, 2, axis=-1)
    return jnp.concatenate([x1 * cos - x2 * sin, x2 * cos + x1 * sin], axis=-1)


def mla_attention(q_nope, q_rope, k_nope, k_rope, v):
    bsz, length = q_nope.shape[:2]
    scale = (QK_NOPE + QK_ROPE) ** -0.5
    pos = jnp.arange(length)

    def attend(qn, qr, qpos, kn, kr, vv, kpos):
        s = jnp.einsum('bqhd,bkhd->bhqk', qn, kn) + jnp.einsum('bqhd,bkd->bhqk', qr, kr)
        s = s.astype(jnp.float32) * scale
        s = jnp.where(kpos[None, None, None, :] <= qpos[None, None, :, None], s, -jnp.inf)
        p = jax.nn.softmax(s, axis=-1).astype(vv.dtype)
        return jnp.einsum('bhqk,bkhd->bqhd', p, vv)

    out_meta = attend(q_nope[:, :N_META], q_rope[:, :N_META], pos[:N_META],
                      k_nope[:, :N_META], k_rope[:, :N_META], v[:, :N_META], pos[:N_META])
    n_blocks = (length - N_META) // Q_BLOCK

    def to_blocks(t):
        t = t[:, N_META:]
        return jnp.moveaxis(t.reshape(bsz, n_blocks, Q_BLOCK, *t.shape[2:]), 1, 0)

    def block_fn(args):
        qn, qr, qp = args
        return attend(qn, qr, qp, k_nope, k_rope, v, pos)

    out_real = lax.map(block_fn, (to_blocks(q_nope), to_blocks(q_rope), pos[N_META:].reshape(n_blocks, Q_BLOCK)))
    out_real = jnp.moveaxis(out_real, 0, 1).reshape(bsz, length - N_META, ATT_HEADS, V_HEAD)
    return jnp.concatenate([out_meta, out_real], axis=1)


def causal_depthwise_conv(u, w, bias):
    out = lax.conv_general_dilated(u, w[:, None, :], window_strides=(1,), padding=((CONV_K - 1, 0),),
                                   dimension_numbers=('NWC', 'WIO', 'NWC'), feature_group_count=u.shape[-1])
    return out + bias


def ssd_chunked(x, dt, a, b_mat, c_mat, state0, chunk):
    bsz, total = x.shape[:2]
    nc = total // chunk

    def chunks(t):
        return t.reshape(bsz, nc, chunk, *t.shape[2:])

    x, dt, b_mat, c_mat = chunks(x), chunks(dt), chunks(b_mat), chunks(c_mat)
    a_cum = jnp.cumsum(dt * a, axis=2)
    seg = a_cum[:, :, :, None] - a_cum[:, :, None, :]
    causal = jnp.tril(jnp.ones((chunk, chunk), dtype=bool))[:, :, None, None]
    decay = jnp.where(causal, jnp.exp(jnp.where(causal, seg, 0.0)), 0.0)
    cb = jnp.einsum('bclgn,bcsgn->bclsg', c_mat, b_mat)
    w_ls = cb[..., None] * decay * dt[:, :, None]
    y_diag = jnp.einsum('bclsgr,bcsgrp->bclgrp', w_ls, x)
    decay_to_end = jnp.exp(a_cum[:, :, -1:] - a_cum)
    states = jnp.einsum('bcsgn,bcsgr,bcsgrp->bcgrpn', b_mat, decay_to_end * dt, x)
    chunk_decay = jnp.exp(a_cum[:, :, -1])

    def step(h, inp):
        dec, st = inp
        return dec[..., None, None] * h + st, h

    final, prev = lax.scan(step, state0, (jnp.moveaxis(chunk_decay, 1, 0), jnp.moveaxis(states, 1, 0)))
    prev = jnp.moveaxis(prev, 0, 1)
    y_off = jnp.einsum('bclgn,bcgrpn,bclgr->bclgrp', c_mat, prev, jnp.exp(a_cum))
    y = (y_diag + y_off).reshape(bsz, total, *x.shape[3:])
    return y, final


def hybrid_mixer(h, w_in, q_a_norm, w_q_up, kv_a_norm, w_kv_up, conv_w, conv_b,
                 dt_bias, a_log, d_skip, ssm_norm, w_out, cos, sin):
    bsz, length, _ = h.shape
    proj = h @ w_in
    c_q, c_kv, k_rope, z, xbc, dt_raw = jnp.split(proj, IN_OFFSETS, axis=-1)

    q = (rmsnorm(c_q, q_a_norm) @ w_q_up).reshape(bsz, length, ATT_HEADS, QK_NOPE + QK_ROPE)
    q_nope, q_rope = q[..., :QK_NOPE], q[..., QK_NOPE:]
    kv = (rmsnorm(c_kv, kv_a_norm) @ w_kv_up).reshape(bsz, length, ATT_HEADS, QK_NOPE + V_HEAD)
    k_nope, v = kv[..., :QK_NOPE], kv[..., QK_NOPE:]
    q_rope = apply_rope(q_rope, cos[None, :, None, :], sin[None, :, None, :])
    k_rope = apply_rope(k_rope, cos[None], sin[None])
    att = mla_attention(q_nope, q_rope, k_nope, k_rope, v).reshape(bsz, length, ATT_WIDTH)

    xbc = jax.nn.silu(causal_depthwise_conv(xbc, conv_w, conv_b))
    xs, bm, cm = jnp.split(xbc, (SSM_WIDTH, SSM_WIDTH + SSM_GROUPS * SSM_STATE), axis=-1)
    xs32 = xs.astype(jnp.float32).reshape(bsz, length, SSM_GROUPS, SSM_HEADS_PER_GROUP, SSM_HEAD_DIM)
    bm = bm.astype(jnp.float32).reshape(bsz, length, SSM_GROUPS, SSM_STATE)
    cm = cm.astype(jnp.float32).reshape(bsz, length, SSM_GROUPS, SSM_STATE)
    dt = jax.nn.softplus(dt_raw.astype(jnp.float32) + dt_bias.astype(jnp.float32))
    dt = dt.reshape(bsz, length, SSM_GROUPS, SSM_HEADS_PER_GROUP)
    a = -jnp.exp(a_log.astype(jnp.float32)).reshape(SSM_GROUPS, SSM_HEADS_PER_GROUP)
    state0 = jnp.zeros((bsz, SSM_GROUPS, SSM_HEADS_PER_GROUP, SSM_HEAD_DIM, SSM_STATE), jnp.float32)
    y_meta, st = ssd_chunked(xs32[:, :N_META], dt[:, :N_META], a, bm[:, :N_META], cm[:, :N_META], state0, N_META)
    y_real, _ = ssd_chunked(xs32[:, N_META:], dt[:, N_META:], a, bm[:, N_META:], cm[:, N_META:], st, CHUNK)
    y = jnp.concatenate([y_meta, y_real], axis=1)
    y = y + d_skip.astype(jnp.float32).reshape(SSM_GROUPS, SSM_HEADS_PER_GROUP)[:, :, None] * xs32
    y = y.reshape(bsz, length, SSM_WIDTH).astype(h.dtype)
    ssm = gated_group_rmsnorm(y, z, ssm_norm)

    return jnp.concatenate([att, ssm], axis=-1) @ w_out


def setup_inputs(seed: int = 0) -> dict:
    key = jax.random.key(seed)
    ks = jax.random.split(key, 24)
    f32 = jnp.float32

    def nrm(k, shape, fan_in):
        return jax.random.normal(k, shape, f32) * (fan_in ** -0.5)

    def gain(k, shape):
        return 1.0 + 0.05 * jax.random.normal(k, shape, f32)

    dt0 = jnp.exp(jax.random.uniform(ks[10], (DEPTH, SSM_HEADS), f32) * (jnp.log(0.1) - jnp.log(0.001)) + jnp.log(0.001))
    return {
        "x": jax.random.normal(ks[0], (BATCH, SEQ, D_MODEL), f32),
        "meta_tokens": jax.random.normal(ks[1], (N_META, D_MODEL), f32),
        "norm_mix_pre": gain(ks[2], (DEPTH, D_MODEL)),
        "w_in": nrm(ks[3], (DEPTH, D_MODEL, IN_WIDTH), D_MODEL),
        "q_a_norm": gain(ks[4], (DEPTH, Q_LORA)),
        "w_q_up": nrm(ks[5], (DEPTH, Q_LORA, ATT_HEADS * (QK_NOPE + QK_ROPE)), Q_LORA),
        "kv_a_norm": gain(ks[6], (DEPTH, KV_LORA)),
        "w_kv_up": nrm(ks[7], (DEPTH, KV_LORA, ATT_HEADS * (QK_NOPE + V_HEAD)), KV_LORA),
        "conv_w": nrm(ks[8], (DEPTH, CONV_K, CONV_DIM), CONV_K),
        "conv_b": 0.01 * jax.random.normal(ks[9], (DEPTH, CONV_DIM), f32),
        "dt_bias": dt0 + jnp.log(-jnp.expm1(-dt0)),
        "a_log": jnp.log(jax.random.uniform(ks[11], (DEPTH, SSM_HEADS), f32, 1.0, 16.0)),
        "d_skip": gain(ks[12], (DEPTH, SSM_HEADS)),
        "ssm_norm": gain(ks[13], (DEPTH, SSM_WIDTH)),
        "w_out": nrm(ks[14], (DEPTH, MIX_WIDTH, D_MODEL), MIX_WIDTH),
        "norm_mix_post": gain(ks[15], (DEPTH, D_MODEL)),
        "norm_mlp_pre": gain(ks[16], (DEPTH, D_MODEL)),
        "w_mlp_up": nrm(ks[17], (DEPTH, D_MODEL, D_FF), D_MODEL),
        "w_mlp_down": nrm(ks[18], (DEPTH, D_FF, D_MODEL), D_FF),
        "norm_mlp_post": gain(ks[19], (DEPTH, D_MODEL)),
    }


def reference(x, meta_tokens, norm_mix_pre, w_in, q_a_norm, w_q_up, kv_a_norm, w_kv_up, conv_w, conv_b,
              dt_bias, a_log, d_skip, ssm_norm, w_out, norm_mix_post, norm_mlp_pre, w_mlp_up, w_mlp_down,
              norm_mlp_post):
    bsz = x.shape[0]
    h = jnp.concatenate([jnp.broadcast_to(meta_tokens[None].astype(x.dtype), (bsz, N_META, D_MODEL)), x], axis=1)
    cos, sin = rope_tables(h.shape[1], h.dtype)
    for layer in range(DEPTH):
        mix = hybrid_mixer(rmsnorm(h, norm_mix_pre[layer]), w_in[layer], q_a_norm[layer], w_q_up[layer],
                           kv_a_norm[layer], w_kv_up[layer], conv_w[layer], conv_b[layer], dt_bias[layer],
                           a_log[layer], d_skip[layer], ssm_norm[layer], w_out[layer], cos, sin)
        h = h + rmsnorm(mix, norm_mix_post[layer])
        f = jnp.square(jax.nn.relu(rmsnorm(h, norm_mlp_pre[layer]) @ w_mlp_up[layer])) @ w_mlp_down[layer]
        h = h + rmsnorm(f, norm_mlp_post[layer])
    return h[:, N_META:]
```

```cpp
#include <hip/hip_runtime.h>
#include <hip/hip_cooperative_groups.h>
#include <cstdio>
#include <cstdint>
#include <cmath>
namespace cg = cooperative_groups;

#ifndef ONE_LAUNCH
#define ONE_LAUNCH 0
#endif

namespace pg8 {
#define PG8_LAS __attribute__((address_space(3)))
typedef unsigned short bf16_t;
typedef short bf16x8 __attribute__((ext_vector_type(8)));
typedef float f32x4 __attribute__((ext_vector_type(4)));
typedef unsigned u32x4 __attribute__((ext_vector_type(4)));
constexpr int BM = 256, BK = 64, HALF = 128, HTB = HALF * BK * 2, STAGE_BYTES = 8 * HTB, NXCD = 8, WGM = 8;

__host__ __device__ __forceinline__ int lds_byte(int r, int c) { const int st = (r >> 4) * 2 + (c >> 5), rr = r & 15, cc = c & 31, ob = rr * 64 + cc * 2; return st * 1024 + (ob ^ (((ob >> 9) & 1) << 5)); }
__host__ __device__ __forceinline__ void stage_rc(int b, int& R, int& C) { const int st = b / 1024, sb = b % 1024, swz = sb ^ (((sb >> 9) & 1) << 5); R = (st >> 1) * 16 + swz / 64; C = (st & 1) * 32 + (swz % 64) / 2; }
__host__ __device__ __forceinline__ int perm32(int rho) { const int n = rho >> 4, i = rho & 15; return 8 * (i >> 2) + 4 * n + (i & 3); }

struct Unit { int pm, pn; };
struct Gemm { const bf16_t* A; const bf16_t* Bt; int M, N, K, lda, ldb; };

struct StaticOrder {
    int nM, nN, nwg, G, c;
    __host__ __device__ void init(int M, int N, int G_, int c_) { nM = M / BM; nN = N / BM; nwg = nM * nN; G = G_; c = c_; }
    __host__ __device__ bool next(int i, Unit& u) const {
        const long L = (long)i * G + c; if (L >= nwg) return false;
        int wgid = (int)L; { const int q = nwg / NXCD, r = nwg % NXCD, xcd = wgid % NXCD, off = wgid / NXCD; wgid = (xcd < r ? xcd * (q + 1) : r * (q + 1) + (xcd - r) * q) + off; }
        const int nig = WGM * nN, gid = wgid / nig, fm = gid * WGM, gsz = (nM - fm) < WGM ? (nM - fm) : WGM;
        u.pm = fm + ((wgid % nig) % gsz); u.pn = (wgid % nig) / gsz; return true;
    }
    __device__ __forceinline__ void a_ready(const Unit&) const {}
    __device__ __forceinline__ void done(const Unit&) const {}
};

typedef float f32x2_t __attribute__((ext_vector_type(2))); typedef __bf16 bf16x2_t __attribute__((ext_vector_type(2)));
__device__ __forceinline__ unsigned cvt_pk_bf16(float lo, float hi) { f32x2_t v = {lo, hi}; bf16x2_t b = __builtin_convertvector(v, bf16x2_t); return __builtin_bit_cast(unsigned, b); }

template <int ACT  > struct EpiBf16 {
    static constexpr bool PERM = true, AFTER_DRAIN = false;
    bf16_t* O; int ldc; float scale;
    __device__ __forceinline__ void operator()(const f32x4 (&acc)[2][2][4][2], const Unit& u, int wr, int wc, int fr, int fq) const {
        const int row0 = u.pm * BM + wr * 64 + fr; const int col0 = u.pn * BM + wc * 32 + 8 * fq;
#pragma unroll
        for (int ai = 0; ai < 2; ++ai)
#pragma unroll
            for (int m = 0; m < 4; ++m) { bf16_t* rowp = O + (size_t)(row0 + ai * HALF + m * 16) * ldc + col0;
#pragma unroll
                for (int bj = 0; bj < 2; ++bj) { f32x4 v0 = acc[ai][bj][m][0], v1 = acc[ai][bj][m][1];
                    if (ACT == 2) {
#pragma unroll
                        for (int i = 0; i < 4; ++i) { float a = v0[i] > 0.f ? v0[i] : 0.f; v0[i] = a * a; float b = v1[i] > 0.f ? v1[i] : 0.f; v1[i] = b * b; } }
                    v0 = v0 * scale; v1 = v1 * scale; u32x4 w; w.x = cvt_pk_bf16(v0[0], v0[1]); w.y = cvt_pk_bf16(v0[2], v0[3]); w.z = cvt_pk_bf16(v1[0], v1[1]); w.w = cvt_pk_bf16(v1[2], v1[3]);
                    *(u32x4*)(rowp + bj * HALF) = w; } }
    }
};
struct EpiF32 {
    static constexpr bool PERM = true, AFTER_DRAIN = false;
    float* O; int ldc;
    __device__ __forceinline__ void operator()(const f32x4 (&acc)[2][2][4][2], const Unit& u, int wr, int wc, int fr, int fq) const {
        const int row0 = u.pm * BM + wr * 64 + fr; const int col0 = u.pn * BM + wc * 32 + 8 * fq;
#pragma unroll
        for (int ai = 0; ai < 2; ++ai)
#pragma unroll
            for (int m = 0; m < 4; ++m) { float* rowp = O + (size_t)(row0 + ai * HALF + m * 16) * ldc + col0;
#pragma unroll
                for (int bj = 0; bj < 2; ++bj) { *(f32x4*)(rowp + bj * HALF) = acc[ai][bj][m][0]; *(f32x4*)(rowp + bj * HALF + 4) = acc[ai][bj][m][1]; } }
    }
};
struct EpiInProj {
    static constexpr bool PERM = true, AFTER_DRAIN = false;
    bf16_t* lat; bf16_t* z; bf16_t* xbc; float* dt; const float* dt_bias;
    __device__ __forceinline__ void operator()(const f32x4 (&acc)[2][2][4][2], const Unit& u, int wr, int wc, int fr, int fq) const {
        const int row0 = u.pm * BM + wr * 64 + fr; const int colb = u.pn * BM + wc * 32 + 8 * fq;
#pragma unroll
        for (int ai = 0; ai < 2; ++ai)
#pragma unroll
            for (int m = 0; m < 4; ++m) { const size_t row = (size_t)(row0 + ai * HALF + m * 16);
#pragma unroll
                for (int bj = 0; bj < 2; ++bj) { const int col = colb + bj * HALF; const f32x4 v0 = acc[ai][bj][m][0], v1 = acc[ai][bj][m][1];
                    if (col < 3264) {
                        u32x4 w; w.x = cvt_pk_bf16(v0[0], v0[1]); w.y = cvt_pk_bf16(v0[2], v0[3]); w.z = cvt_pk_bf16(v1[0], v1[1]); w.w = cvt_pk_bf16(v1[2], v1[3]);
                        bf16_t* p;
                        if (col < 704) p = lat + row * 704 + col; else if (col < 1728) p = z + row * 1024 + (col - 704); else p = xbc + row * 1536 + (col - 1728);
                        *(u32x4*)p = w;
                    } else if (col < 3280) {
                        const int c0 = col - 3264; f32x4 o0, o1;
#pragma unroll
                        for (int i = 0; i < 4; ++i) { float a = v0[i] + dt_bias[c0 + i]; o0[i] = fmaxf(a, 0.f) + log1pf(__expf(-fabsf(a))); float b = v1[i] + dt_bias[c0 + 4 + i]; o1[i] = fmaxf(b, 0.f) + log1pf(__expf(-fabsf(b))); }
                        *(f32x4*)(dt + row * 16 + c0) = o0; *(f32x4*)(dt + row * 16 + c0 + 4) = o1;
                    } } }
    }
};

template <class Epi, class Sched, bool ALIGN_EPI = false, bool SP2 = false>
__device__ __forceinline__ void gemm_phase(PG8_LAS unsigned char* lds, const Gemm g, const Sched& S, const Epi& E) {
    const int tid = threadIdx.x, wid = __builtin_amdgcn_readfirstlane(tid >> 6), lane = tid & 63, wr = wid >> 2, wc = wid & 3, fr = lane & 15, fq = lane >> 4;
    const int K = g.K, nt = K / BK;
    unsigned voffA[2], voffB[2];
#pragma unroll
    for (int i = 0; i < 2; ++i) { int R, C; stage_rc(tid * 16 + i * 8192, R, C); const int Rb = Epi::PERM ? ((R & ~31) + perm32(R & 31)) : R;
        voffA[i] = (unsigned)(R * g.lda + C) * 2u; voffB[i] = (unsigned)(Rb * g.ldb + C) * 2u; }
    const size_t kstep = (size_t)(BK * 2);
    const size_t hstepA = (size_t)HALF * g.lda * 2, hstepB = (size_t)HALF * g.ldb * 2;
    const size_t tstepA = 2 * hstepA, tstepB = 2 * hstepB;
    const unsigned ldsw = (unsigned)wid * 1024u;
    const int aoff = lds_byte(wr * 64 + fr, fq * 8), boff = lds_byte(wc * 32 + fr, fq * 8);
#define PG8_SA(b, h) (((b) * 2 + (h)) * HTB)
#define PG8_SB(b, h) ((4 + (b) * 2 + (h)) * HTB)
#define PG8_STAGE(bufoff, gbase, voff) do { _Pragma("unroll") for (int _i = 0; _i < 2; ++_i) \
        __builtin_amdgcn_global_load_lds((const unsigned*)((const char*)(gbase) + (voff)[_i]), (PG8_LAS unsigned*)(lds + (bufoff) + ldsw + _i * 8192), 16, 0, 0); } while (0)
#define PG8_LDA(dst, b, h) do { _Pragma("unroll") for (int m = 0; m < 4; ++m) _Pragma("unroll") for (int k = 0; k < 2; ++k) dst[m][k] = *(const PG8_LAS bf16x8*)(lds + PG8_SA(b, h) + aoff + m * 2048 + k * 1024); } while (0)
#define PG8_LDB(dst, b, h) do { _Pragma("unroll") for (int n = 0; n < 2; ++n) _Pragma("unroll") for (int k = 0; k < 2; ++k) dst[n][k] = *(const PG8_LAS bf16x8*)(lds + PG8_SB(b, h) + boff + n * 2048 + k * 1024); } while (0)
#define PG8_MMA(ai, bj, At, Bt) do { __builtin_amdgcn_s_setprio(1); _Pragma("unroll") for (int m = 0; m < 4; ++m) _Pragma("unroll") for (int n = 0; n < 2; ++n) _Pragma("unroll") for (int k = 0; k < 2; ++k) \
        acc[ai][bj][m][n] = __builtin_amdgcn_mfma_f32_16x16x32_bf16(Bt[n][k], At[m][k], acc[ai][bj][m][n], 0, 0, 0); __builtin_amdgcn_s_setprio(0); } while (0)
#define PG8_WAIT_V(n) asm volatile("s_waitcnt vmcnt(" #n ")" ::: "memory")
#define PG8_WAIT_L(n) asm volatile("s_waitcnt lgkmcnt(" #n ")" ::: "memory")
#define PG8_BAR __builtin_amdgcn_s_barrier()
#define PG8_SCHED __builtin_amdgcn_sched_barrier(0)
    Unit cur, nxt; int ui = 0;
    if (!S.next(0, cur)) return;
    f32x4 acc[2][2][4][2];
#pragma unroll
    for (int a = 0; a < 2; ++a)
#pragma unroll
        for (int b = 0; b < 2; ++b)
#pragma unroll
            for (int m = 0; m < 4; ++m)
#pragma unroll
                for (int n = 0; n < 2; ++n) acc[a][b][m][n] = (f32x4){0.f, 0.f, 0.f, 0.f};
    bf16x8 At[4][2], B0[2][2], B1[2][2];
    const char* cA = (const char*)g.A + (size_t)cur.pm * tstepA; const char* cB = (const char*)g.Bt + (size_t)cur.pn * tstepB;
    S.a_ready(cur);
    if constexpr (SP2) {
        PG8_STAGE(PG8_SB(0, 0), cB, voffB); PG8_STAGE(PG8_SB(0, 1), cB + hstepB, voffB); PG8_STAGE(PG8_SA(0, 0), cA, voffA); PG8_STAGE(PG8_SA(0, 1), cA + hstepA, voffA);
        if (wr == 1) PG8_BAR;
        PG8_WAIT_V(2); PG8_BAR;
        PG8_STAGE(PG8_SB(1, 0), cB + kstep, voffB); PG8_STAGE(PG8_SA(1, 0), cA + kstep, voffA); PG8_STAGE(PG8_SB(1, 1), cB + hstepB + kstep, voffB);
        PG8_WAIT_V(6); PG8_BAR;
    } else {
        PG8_STAGE(PG8_SB(0, 0), cB, voffB); PG8_STAGE(PG8_SA(0, 0), cA, voffA); PG8_STAGE(PG8_SB(0, 1), cB + hstepB, voffB); PG8_STAGE(PG8_SA(0, 1), cA + hstepA, voffA);
        if (wr == 1) PG8_BAR;
        PG8_WAIT_V(4); PG8_BAR;
        PG8_STAGE(PG8_SB(1, 0), cB + kstep, voffB); PG8_STAGE(PG8_SA(1, 0), cA + kstep, voffA); PG8_STAGE(PG8_SB(1, 1), cB + hstepB + kstep, voffB);
        PG8_WAIT_V(6); PG8_BAR;
    }
    for (;;) {
        const bool has_next = S.next(ui + 1, nxt);
        const char* nA = has_next ? (const char*)g.A + (size_t)nxt.pm * tstepA : cA; const char* nB = has_next ? (const char*)g.Bt + (size_t)nxt.pn * tstepB : cB;
        for (int t = 0; t < nt; t += 2) {
            const bool last = (t == nt - 2);
            const char* a1 = cA + (size_t)(t + 1) * kstep;
            const char* a2 = last ? nA : cA + (size_t)(t + 2) * kstep; const char* b2 = last ? nB : cB + (size_t)(t + 2) * kstep;
            const char* a3 = a2 + kstep; const char* b3 = b2 + kstep;
            if (last && has_next) S.a_ready(nxt);
            if constexpr (SP2) {
            PG8_LDB(B0, 0, 0); PG8_LDB(B1, 0, 1); PG8_SCHED; PG8_LDA(At, 0, 0); PG8_STAGE(PG8_SA(1, 1), a1 + hstepA, voffA);
            PG8_WAIT_V(8); PG8_WAIT_L(0); PG8_BAR; PG8_MMA(0, 0, At, B0); PG8_MMA(0, 1, At, B1); PG8_BAR; PG8_SCHED;
            PG8_LDA(At, 0, 1); PG8_STAGE(PG8_SB(0, 0), b2, voffB); PG8_STAGE(PG8_SB(0, 1), b2 + hstepB, voffB); PG8_STAGE(PG8_SA(0, 0), a2, voffA);
            PG8_WAIT_V(8); PG8_WAIT_L(0); PG8_BAR; PG8_MMA(1, 0, At, B0); PG8_MMA(1, 1, At, B1); PG8_BAR; PG8_SCHED;
            PG8_LDB(B0, 1, 0); PG8_LDB(B1, 1, 1); PG8_SCHED; PG8_LDA(At, 1, 0); PG8_STAGE(PG8_SA(0, 1), a2 + hstepA, voffA);
            PG8_WAIT_V(8); PG8_WAIT_L(0); PG8_BAR; PG8_MMA(0, 0, At, B0); PG8_MMA(0, 1, At, B1); PG8_BAR; PG8_SCHED;
            PG8_LDA(At, 1, 1); PG8_STAGE(PG8_SB(1, 0), b3, voffB); PG8_STAGE(PG8_SB(1, 1), b3 + hstepB, voffB); PG8_STAGE(PG8_SA(1, 0), a3, voffA);
            PG8_WAIT_V(8); PG8_WAIT_L(0); PG8_BAR; PG8_MMA(1, 0, At, B0); PG8_MMA(1, 1, At, B1); PG8_BAR; PG8_SCHED;
            } else {
            PG8_LDB(B0, 0, 0); PG8_SCHED; PG8_LDA(At, 0, 0); PG8_STAGE(PG8_SA(1, 1), a1 + hstepA, voffA);
            PG8_WAIT_L(8); PG8_BAR; PG8_WAIT_L(0); PG8_MMA(0, 0, At, B0); PG8_BAR; PG8_SCHED;
            PG8_LDB(B1, 0, 1); PG8_STAGE(PG8_SB(0, 0), b2, voffB);
            PG8_BAR; PG8_WAIT_L(0); PG8_MMA(0, 1, At, B1); PG8_BAR;
            PG8_LDA(At, 0, 1); PG8_STAGE(PG8_SA(0, 0), a2, voffA);
            PG8_BAR; PG8_WAIT_L(0); PG8_MMA(1, 0, At, B0); PG8_BAR; PG8_SCHED;
            PG8_STAGE(PG8_SB(0, 1), b2 + hstepB, voffB);
            PG8_WAIT_V(6); PG8_BAR; PG8_MMA(1, 1, At, B1); PG8_BAR;
            PG8_LDB(B0, 1, 0); PG8_SCHED; PG8_LDA(At, 1, 0); PG8_STAGE(PG8_SA(0, 1), a2 + hstepA, voffA);
            PG8_WAIT_L(8); PG8_BAR; PG8_WAIT_L(0); PG8_MMA(0, 0, At, B0); PG8_BAR; PG8_SCHED;
            PG8_LDB(B1, 1, 1); PG8_STAGE(PG8_SB(1, 0), b3, voffB);
            PG8_BAR; PG8_WAIT_L(0); PG8_MMA(0, 1, At, B1); PG8_BAR;
            PG8_LDA(At, 1, 1); PG8_STAGE(PG8_SA(1, 0), a3, voffA);
            PG8_BAR; PG8_WAIT_L(0); PG8_MMA(1, 0, At, B0); PG8_BAR; PG8_SCHED;
            PG8_STAGE(PG8_SB(1, 1), b3 + hstepB, voffB);
            PG8_WAIT_V(6); PG8_BAR; PG8_MMA(1, 1, At, B1); PG8_BAR;
            }
        }
        if constexpr (ALIGN_EPI) { if (wr == 0) PG8_BAR; }
        if constexpr (!Epi::AFTER_DRAIN) { E(acc, cur, wr, wc, fr, fq); S.done(cur); }
        if (!has_next) break;
#pragma unroll
        for (int a = 0; a < 2; ++a)
#pragma unroll
            for (int b = 0; b < 2; ++b)
#pragma unroll
                for (int m = 0; m < 4; ++m)
#pragma unroll
                    for (int n = 0; n < 2; ++n) acc[a][b][m][n] = (f32x4){0.f, 0.f, 0.f, 0.f};
        cur = nxt; cA = nA; cB = nB; ++ui;
        if constexpr (ALIGN_EPI) { if (wr == 1) PG8_BAR; }
    }
    PG8_WAIT_V(0);
    if constexpr (!ALIGN_EPI) { if (wr == 0) PG8_BAR; }
    PG8_BAR;
#undef PG8_SA
#undef PG8_SB
#undef PG8_STAGE
#undef PG8_LDA
#undef PG8_LDB
#undef PG8_MMA
#undef PG8_WAIT_V
#undef PG8_WAIT_L
#undef PG8_BAR
#undef PG8_SCHED
}
}

typedef unsigned short bf16_t;
typedef short bf16x8 __attribute__((ext_vector_type(8)));
typedef float f32x16 __attribute__((ext_vector_type(16)));
typedef float f32x4 __attribute__((ext_vector_type(4)));
typedef unsigned u32x4 __attribute__((ext_vector_type(4)));
typedef unsigned u32x2 __attribute__((ext_vector_type(2)));

constexpr int DM = 1024, SEQ = 16384, NMETA = 16, L = SEQ + NMETA  , MP = 16640  ;
constexpr int INW = 3280, INWP = 3328, LATW = 704, QW = 1536, XBCW = 1536, DFF = 4096;
constexpr int NCH = 129;
constexpr float EPS = 1e-6f;
constexpr float QSCALE = 0.07216878364870322f * 1.4426950408889634f;
constexpr size_t MiB = 1u << 20;
constexpr size_t WS_WIN = 1 * MiB, WS_WQ = WS_WIN + (size_t)INWP * 1024 * 2, WS_WK = WS_WQ + (size_t)1536 * 384 * 2, WS_WV = WS_WK + (size_t)1024 * 256 * 2;
constexpr size_t WS_WOUT = 10 * MiB, WS_WUP = 14 * MiB, WS_WDN = 22 * MiB;
constexpr size_t WS_DT = 30 * MiB, WS_CDEC = 31 * MiB + 512 * 1024, WS_ROPE = 32 * MiB;
constexpr size_t WS_MIX = 37 * MiB;
constexpr size_t WS_HN = 37 * MiB;
constexpr size_t WS_LAT = 102 * MiB;
constexpr size_t WS_Z = 124 * MiB + 512 * 1024;
constexpr size_t WS_XBC = 157 * MiB;
constexpr size_t WS_ST = 205 * MiB + 768 * 1024;
constexpr size_t WS_KR = 253 * MiB;
constexpr size_t WS_Q = WS_Z;
constexpr size_t WS_K = 173 * MiB + 256 * 1024;
constexpr size_t WS_VT = 205 * MiB + 768 * 1024;
constexpr size_t WS_MIXO = 102 * MiB;
constexpr size_t WS_HN2 = 224 * MiB;
constexpr size_t WS_FF = 37 * MiB;
constexpr size_t WS_F = 165 * MiB;
static_assert(WS_WV + (size_t)1024 * 256 * 2 <= WS_WOUT, "w");
static_assert(WS_ROPE + (size_t)L * 32 * 8 <= WS_MIX, "rope");
static_assert(WS_MIX + (size_t)MP * 2048 * 2 <= WS_LAT, "mix");
static_assert(WS_LAT + (size_t)MP * 704 * 2 <= WS_Z, "lat");
static_assert(WS_Z + (size_t)MP * 1024 * 2 <= WS_XBC, "z");
static_assert(WS_XBC + (size_t)MP * 1536 * 2 <= WS_ST, "xbc");
static_assert(WS_ST + (size_t)NCH * 131072 * 2 <= WS_KR, "st");
static_assert(WS_KR + (size_t)MP * 64 * 2 <= 256 * MiB, "kr");
static_assert(WS_Q + (size_t)MP * 1536 * 2 <= WS_K && WS_K + (size_t)MP * 1024 * 2 <= WS_VT && WS_VT + (size_t)1024 * MP * 2 <= WS_KR, "qkv");
static_assert(WS_MIXO + (size_t)SEQ * 1024 * 4 <= WS_HN2 && WS_FF + (size_t)SEQ * 4096 * 2 <= WS_F && WS_F + (size_t)SEQ * 1024 * 4 <= 256 * MiB, "tail");

constexpr int LDS_BYTES = 156 * 1024;
constexpr int NPHASE = 12;

struct Params {
    const float *x, *meta, *g_mix_pre, *w_in, *g_qa, *w_q_up, *g_kva, *w_kv_up, *conv_w, *conv_b, *dt_bias, *a_log, *d_skip, *g_ssm, *w_out, *g_mix_post, *g_mlp_pre, *w_up, *w_dn, *g_mlp_post;
    float* out; unsigned char* ws;
    float invf[32];
    int ph_lo, ph_hi;
};

__device__ __forceinline__ float bf_lo(unsigned u) { return __uint_as_float(u << 16); }
__device__ __forceinline__ float bf_hi(unsigned u) { return __uint_as_float(u & 0xffff0000u); }
__device__ __forceinline__ float bf2f(bf16_t b) { return __uint_as_float(((unsigned)b) << 16); }
__device__ __forceinline__ unsigned pk2(float lo, float hi) { return pg8::cvt_pk_bf16(lo, hi); }
__device__ __forceinline__ bf16_t f2bf(float f) { return (bf16_t)(pk2(f, 0.f) & 0xffffu); }
__device__ __forceinline__ float wave_sum(float v) {
#pragma unroll
    for (int o = 1; o < 64; o <<= 1) v += __shfl_xor(v, o);
    return v;
}
__device__ __forceinline__ float silu(float v) { return v / (1.f + __expf(-v)); }

__device__ __forceinline__ void p0_transpose_item(const float* W, int K, int ldsrc, bf16_t* WT, float* scr, int k0, int n0, int scol0, int nvalid, int lane) {
    const bool ok = (n0 + (lane & 31)) < nvalid;
#pragma unroll 8
    for (int i = 0; i < 32; ++i) { const int kk = 2 * i + (lane >> 5); scr[kk * 33 + (lane & 31)] = ok ? W[(size_t)(k0 + kk) * ldsrc + scol0 + (lane & 31)] : 0.f; }
    __builtin_amdgcn_s_waitcnt(0); asm volatile("" ::: "memory");
    const int c = lane & 7;
#pragma unroll
    for (int j = 0; j < 4; ++j) { const int n = (lane >> 3) + 8 * j; const float* s = scr + (8 * c) * 33 + n;
        u32x4 o; o.x = pk2(s[0 * 33], s[1 * 33]); o.y = pk2(s[2 * 33], s[3 * 33]); o.z = pk2(s[4 * 33], s[5 * 33]); o.w = pk2(s[6 * 33], s[7 * 33]);
        *(u32x4*)(WT + (size_t)(n0 + n) * K + k0 + 8 * c) = o; }
    __builtin_amdgcn_s_waitcnt(0); asm volatile("" ::: "memory");
}

__device__ __forceinline__ void sincos_acc(float a, float& c, float& s) {
    const double x = (double)a; const double k = rint(x * 0.63661977236758134308);
    const double r = fma(-k, 1.57079632679489661923, x), r2 = r * r;
    double sp = -2.5052108385441718775e-8; sp = sp * r2 + 2.7557319223985890653e-6; sp = sp * r2 - 1.9841269841269841270e-4; sp = sp * r2 + 8.3333333333333333333e-3; sp = sp * r2 - 1.6666666666666666667e-1; sp = r + r * r2 * sp;
    double cp = 2.0876756987868098979e-9; cp = cp * r2 - 2.7557319223985890653e-7; cp = cp * r2 + 2.4801587301587301587e-5; cp = cp * r2 - 1.3888888888888888889e-3; cp = cp * r2 + 4.1666666666666666667e-2; cp = cp * r2 - 0.5; cp = 1.0 + r2 * cp;
    const int q = ((int)k) & 3;
    const double sv = (q == 0) ? sp : (q == 1) ? cp : (q == 2) ? -sp : -cp;
    const double cv = (q == 0) ? cp : (q == 1) ? -sp : (q == 2) ? -cp : sp;
    c = (float)cv; s = (float)sv;
}

__device__ __forceinline__ void phase0(const Params& P, unsigned char* lds, int gw, int NGW, int wave, int lane) {
    unsigned char* ws = P.ws;
    float* scr = (float*)(lds + wave * 8704);
    constexpr int I_IN = 16 * 104, I_Q = 6 * 48, I_K = 4 * 32, I_V = 4 * 32, I_O = 32 * 32, I_U = 16 * 128, I_D = 64 * 32;
    constexpr int NIT = I_IN + I_Q + I_K + I_V + I_O + I_U + I_D;
    for (int it = gw; it < NIT; it += NGW) {
        int r = it;
        if (r < I_IN) { const int kb = r / 104, nb = r % 104; p0_transpose_item(P.w_in, 1024, INW, (bf16_t*)(ws + WS_WIN), scr, kb * 64, nb * 32, nb * 32, INW, lane); continue; } r -= I_IN;
        if (r < I_Q) { const int kb = r / 48, nb = r % 48; p0_transpose_item(P.w_q_up, 384, 1536, (bf16_t*)(ws + WS_WQ), scr, kb * 64, nb * 32, nb * 32, 1536, lane); continue; } r -= I_Q;
        if (r < I_K) { const int kb = r / 32, nb = r % 32, n0 = nb * 32; p0_transpose_item(P.w_kv_up, 256, 2048, (bf16_t*)(ws + WS_WK), scr, kb * 64, n0, 256 * (n0 >> 7) + (n0 & 127), 1024, lane); continue; } r -= I_K;
        if (r < I_V) { const int kb = r / 32, nb = r % 32, n0 = nb * 32; p0_transpose_item(P.w_kv_up, 256, 2048, (bf16_t*)(ws + WS_WV), scr, kb * 64, n0, 256 * (n0 >> 7) + 128 + (n0 & 127), 1024, lane); continue; } r -= I_V;
        if (r < I_O) { const int kb = r / 32, nb = r % 32; p0_transpose_item(P.w_out, 2048, 1024, (bf16_t*)(ws + WS_WOUT), scr, kb * 64, nb * 32, nb * 32, 1024, lane); continue; } r -= I_O;
        if (r < I_U) { const int kb = r / 128, nb = r % 128; p0_transpose_item(P.w_up, 1024, 4096, (bf16_t*)(ws + WS_WUP), scr, kb * 64, nb * 32, nb * 32, 4096, lane); continue; } r -= I_U;
        { const int kb = r / 32, nb = r % 32; p0_transpose_item(P.w_dn, 4096, 1024, (bf16_t*)(ws + WS_WDN), scr, kb * 64, nb * 32, nb * 32, 1024, lane); }
    }
    bf16_t* hn = (bf16_t*)(ws + WS_HN);
    for (int m = gw; m < MP; m += NGW) {
        unsigned long long* o8 = (unsigned long long*)(hn + (size_t)m * DM) + lane;
        if (m >= L) {
#pragma unroll
            for (int j = 0; j < 4; ++j) o8[64 * j] = 0ull;
            continue; }
        const float* xrow = (m < NMETA) ? (P.meta + (size_t)m * DM) : (P.x + (size_t)(m - NMETA) * DM);
        const f32x4* xr = (const f32x4*)xrow + lane; const f32x4* gr = (const f32x4*)P.g_mix_pre + lane;
        f32x4 v[4]; float s = 0.f;
#pragma unroll
        for (int j = 0; j < 4; ++j) { v[j] = xr[64 * j]; s += (v[j].x * v[j].x + v[j].y * v[j].y) + (v[j].z * v[j].z + v[j].w * v[j].w); }
        const float rstd = rsqrtf(wave_sum(s) * (1.f / DM) + EPS);
#pragma unroll
        for (int j = 0; j < 4; ++j) { const f32x4 g = gr[64 * j];
            o8[64 * j] = (unsigned long long)pk2(v[j].x * rstd * g.x, v[j].y * rstd * g.y) | ((unsigned long long)pk2(v[j].z * rstd * g.z, v[j].w * rstd * g.w) << 32); }
    }
    float2* rope = (float2*)(ws + WS_ROPE);
    for (int i = gw * 64 + lane; i < L * 32; i += NGW * 64) { const int pos = i >> 5, j = i & 31; const float a = (float)pos * P.invf[j]; float c, s; sincos_acc(a, c, s); rope[i] = make_float2(c, s); }
}

__device__ __forceinline__ void phase_latn(const Params& P, int gw, int NGW, int lane) {
    bf16_t* lat = (bf16_t*)(P.ws + WS_LAT); bf16_t* kr = (bf16_t*)(P.ws + WS_KR); const float2* rope = (const float2*)(P.ws + WS_ROPE);
    for (int m = gw; m < MP; m += NGW) {
        bf16_t* row = lat + (size_t)m * LATW;
        float q[6], kv[4]; float sq = 0.f, sk = 0.f;
#pragma unroll
        for (int i = 0; i < 6; ++i) { q[i] = bf2f(row[lane + 64 * i]); sq += q[i] * q[i]; }
#pragma unroll
        for (int i = 0; i < 4; ++i) { kv[i] = bf2f(row[384 + lane + 64 * i]); sk += kv[i] * kv[i]; }
        const float rq = rsqrtf(wave_sum(sq) * (1.f / 384.f) + EPS), rk = rsqrtf(wave_sum(sk) * (1.f / 256.f) + EPS);
        float x1 = 0.f, x2 = 0.f;
        if (lane < 32) { x1 = bf2f(row[640 + lane]); x2 = bf2f(row[672 + lane]); }
#pragma unroll
        for (int i = 0; i < 6; ++i) row[lane + 64 * i] = f2bf(q[i] * rq * P.g_qa[lane + 64 * i]);
#pragma unroll
        for (int i = 0; i < 4; ++i) row[384 + lane + 64 * i] = f2bf(kv[i] * rk * P.g_kva[lane + 64 * i]);
        if (lane < 32) {
            float o1 = 0.f, o2 = 0.f;
            if (m < L) { const float2 cs = rope[m * 32 + lane]; o1 = x1 * cs.x - x2 * cs.y; o2 = x2 * cs.x + x1 * cs.y; }
            kr[(size_t)m * 64 + lane] = f2bf(o1); kr[(size_t)m * 64 + 32 + lane] = f2bf(o2);
        }
    }
}

__device__ __forceinline__ void conv8(const bf16_t* xbc, const float* cw, const float* cb, int t, int ch, float (&o)[8]) {
    { const f32x4 b0 = *(const f32x4*)(cb + ch), b1 = *(const f32x4*)(cb + ch + 4); o[0] = b0.x; o[1] = b0.y; o[2] = b0.z; o[3] = b0.w; o[4] = b1.x; o[5] = b1.y; o[6] = b1.z; o[7] = b1.w; }
#pragma unroll
    for (int k = 0; k < 4; ++k) { const int tt = t - 3 + k;
        if (tt >= 0) { const u32x4 u = *(const u32x4*)(xbc + (size_t)tt * XBCW + ch); const f32x4 w0 = *(const f32x4*)(cw + k * XBCW + ch), w1 = *(const f32x4*)(cw + k * XBCW + ch + 4);
            o[0] += w0.x * bf_lo(u.x); o[1] += w0.y * bf_hi(u.x); o[2] += w0.z * bf_lo(u.y); o[3] += w0.w * bf_hi(u.y);
            o[4] += w1.x * bf_lo(u.z); o[5] += w1.y * bf_hi(u.z); o[6] += w1.z * bf_lo(u.w); o[7] += w1.w * bf_hi(u.w); } }
#pragma unroll
    for (int i = 0; i < 8; ++i) o[i] = silu(o[i]);
}
__device__ __forceinline__ int pi32(int m) { const int a = m >> 3, h = (m >> 2) & 1, b = m & 3; return 16 * (a >> 1) + 8 * h + 4 * (a & 1) + b; }
__device__ __forceinline__ int crow(int r, int hi) { return (r & 3) + 8 * (r >> 2) + 4 * hi; }

constexpr int SP = 272;
__device__ __forceinline__ float chunk_scan(const float* dtg, int r0, int valid, int h, float ah, float* acum, float* dtv, int lane) {
    const int s0 = 2 * lane, s1 = 2 * lane + 1;
    const float d0 = (s0 < valid) ? dtg[(size_t)(r0 + s0) * 16 + h] : 0.f, d1 = (s1 < valid) ? dtg[(size_t)(r0 + s1) * 16 + h] : 0.f;
    const float a0 = d0 * ah, a1 = d1 * ah, c = a0 + a1; float incl = c;
#pragma unroll
    for (int o = 1; o < 64; o <<= 1) { const float t = __shfl_up(incl, o); if (lane >= o) incl += t; }
    const float excl = incl - c;
    acum[s0] = excl + a0; acum[s1] = incl; dtv[s0] = d0; dtv[s1] = d1;
    return __shfl(incl, 63);
}

__device__ __forceinline__ void phase_ssd_states(const Params& P, unsigned char* lds, int tid, int wave, int lane) {
    const bf16_t* xbc = (const bf16_t*)(P.ws + WS_XBC); const float* dtg = (const float*)(P.ws + WS_DT);
    bf16_t* st = (bf16_t*)(P.ws + WS_ST); float* cdec = (float*)(P.ws + WS_CDEC);
    unsigned char* Bt = lds;
    unsigned char* XT = lds + 128 * SP + wave * (32 * SP);
    float* acum = (float*)(lds + 128 * SP + 8 * 32 * SP) + wave * 256; float* wts = acum + 128;
    const int r32 = lane & 31, hi = lane >> 5;
    for (int item = blockIdx.x; item < NCH * 2; item += gridDim.x) {
        const int c = item >> 1, g = item & 1; const int r0 = (c == 0) ? 0 : NMETA + 128 * (c - 1), valid = (c == 0) ? NMETA : 128;
        __syncthreads();
        for (int ck = tid; ck < 2048; ck += 512) { const int s = ck >> 4, n8 = (ck & 15) * 8; float o[8]; conv8(xbc, P.conv_w, P.conv_b, r0 + s, 1024 + g * 128 + n8, o);
#pragma unroll
            for (int i = 0; i < 8; ++i) *(bf16_t*)(Bt + (n8 + i) * SP + s * 2) = f2bf(o[i]); }
        const int h = g * 8 + wave; const float ah = -__expf(P.a_log[h]);
        const float total = chunk_scan(dtg, r0, valid, h, ah, acum, wts + 0, lane);
        { const int s0 = 2 * lane; const float w0 = __expf(total - acum[s0]) * wts[s0], w1 = __expf(total - acum[s0 + 1]) * wts[s0 + 1]; wts[s0] = w0; wts[s0 + 1] = w1; }
        if (lane == 0) cdec[c * 16 + h] = __expf(total);
        __syncthreads();
        for (int ph = 0; ph < 2; ++ph) {
            for (int ck = lane; ck < 512; ck += 64) { const int s = ck >> 2, p8 = (ck & 3) * 8; float o[8]; conv8(xbc, P.conv_w, P.conv_b, r0 + s, h * 64 + ph * 32 + p8, o); const float w = wts[s];
#pragma unroll
                for (int i = 0; i < 8; ++i) *(bf16_t*)(XT + (p8 + i) * SP + s * 2) = f2bf(o[i] * w); }
            __builtin_amdgcn_s_waitcnt(0); asm volatile("" ::: "memory");
            f32x16 acc[4];
#pragma unroll
            for (int nb = 0; nb < 4; ++nb) acc[nb] = f32x16{};
#pragma unroll
            for (int ks = 0; ks < 8; ++ks) { const bf16x8 xf = *(const bf16x8*)(XT + r32 * SP + (16 * ks + 8 * hi) * 2);
#pragma unroll
                for (int nb = 0; nb < 4; ++nb) { const bf16x8 bfr = *(const bf16x8*)(Bt + (32 * nb + r32) * SP + (16 * ks + 8 * hi) * 2);
                    acc[nb] = __builtin_amdgcn_mfma_f32_32x32x16_bf16(bfr, xf, acc[nb], 0, 0, 0); } }
            bf16_t* so = st + ((size_t)c * 16 + h) * 8192 + (size_t)(ph * 32 + r32) * 128;
#pragma unroll
            for (int nb = 0; nb < 4; ++nb)
#pragma unroll
                for (int rg = 0; rg < 4; ++rg) { u32x2 w; w.x = pk2(acc[nb][4 * rg], acc[nb][4 * rg + 1]); w.y = pk2(acc[nb][4 * rg + 2], acc[nb][4 * rg + 3]);
                    *(u32x2*)(so + 32 * nb + 8 * rg + 4 * hi) = w; }
            __builtin_amdgcn_s_waitcnt(0); asm volatile("" ::: "memory");
        }
    }
    __syncthreads();
}

__device__ __forceinline__ void phase_scan(const Params& P, int tid) {
    bf16_t* st = (bf16_t*)(P.ws + WS_ST); const float* cdec = (const float*)(P.ws + WS_CDEC);
    for (int e = blockIdx.x * 512 + tid; e < 131072; e += gridDim.x * 512) {
        const int h = e >> 13; float hs = 0.f;
        int c = 0;
        for (; c + 8 <= NCH; c += 8) { float v[8];
#pragma unroll
            for (int i = 0; i < 8; ++i) v[i] = bf2f(st[(size_t)(c + i) * 131072 + e]);
#pragma unroll
            for (int i = 0; i < 8; ++i) { st[(size_t)(c + i) * 131072 + e] = f2bf(hs); hs = cdec[(c + i) * 16 + h] * hs + v[i]; } }
        for (; c < NCH; ++c) { const float v = bf2f(st[(size_t)c * 131072 + e]); st[(size_t)c * 131072 + e] = f2bf(hs); hs = cdec[c * 16 + h] * hs + v; }
    }
}

__device__ __forceinline__ void phase_ssd_y(const Params& P, unsigned char* lds, int tid, int wave, int lane) {
    const bf16_t* xbc = (const bf16_t*)(P.ws + WS_XBC); const float* dtg = (const float*)(P.ws + WS_DT); const bf16_t* zb = (const bf16_t*)(P.ws + WS_Z);
    const bf16_t* st = (const bf16_t*)(P.ws + WS_ST); bf16_t* mix = (bf16_t*)(P.ws + WS_MIX);
    unsigned char* Bs = lds; unsigned char* Cs = lds + 128 * SP;
    unsigned char* XT = lds + 2 * 128 * SP + wave * (32 * SP);
    float* acum = (float*)(lds + 2 * 128 * SP + 8 * 32 * SP) + wave * 256; float* dtv = acum + 128;
    float* rowss = (float*)(lds + 2 * 128 * SP + 8 * 32 * SP + 8 * 1024);
    const int r32 = lane & 31, hi = lane >> 5;
    for (int item = blockIdx.x; item < NCH * 2; item += gridDim.x) {
        const int c = item >> 1, g = item & 1; const int r0 = (c == 0) ? 0 : NMETA + 128 * (c - 1), valid = (c == 0) ? NMETA : 128;
        __syncthreads();
        for (int ck = tid; ck < 4096; ck += 512) { const int isC = ck >> 11, c2 = ck & 2047, s = c2 >> 4, n8 = (c2 & 15) * 8; float o[8]; conv8(xbc, P.conv_w, P.conv_b, r0 + s, 1024 + isC * 256 + g * 128 + n8, o);
            u32x4 w; w.x = pk2(o[0], o[1]); w.y = pk2(o[2], o[3]); w.z = pk2(o[4], o[5]); w.w = pk2(o[6], o[7]);
            *(u32x4*)((isC ? Cs : Bs) + s * SP + n8 * 2) = w; }
        const int h = g * 8 + wave; const float ah = -__expf(P.a_log[h]); const float dsk = P.d_skip[h];
        (void)chunk_scan(dtg, r0, valid, h, ah, acum, dtv, lane);
        __syncthreads();
        for (int ph = 0; ph < 2; ++ph) {
            for (int ck = lane; ck < 512; ck += 64) { const int s = ck >> 2, p8 = (ck & 3) * 8; float o[8]; conv8(xbc, P.conv_w, P.conv_b, r0 + s, h * 64 + ph * 32 + p8, o);
#pragma unroll
                for (int i = 0; i < 8; ++i) *(bf16_t*)(XT + (p8 + i) * SP + s * 2) = f2bf(o[i]); }
            bf16x8 pvf[8];
            { const bf16_t* pv = st + ((size_t)c * 16 + h) * 8192 + (size_t)(ph * 32 + r32) * 128 + 8 * hi;
#pragma unroll
              for (int ks = 0; ks < 8; ++ks) pvf[ks] = *(const bf16x8*)(pv + 16 * ks); }
            __builtin_amdgcn_s_waitcnt(0); asm volatile("" ::: "memory");
            for (int lb = 0; lb < 4; ++lb) {
                const int l = 32 * lb + r32;
                bf16x8 cf[8];
#pragma unroll
                for (int ks = 0; ks < 8; ++ks) cf[ks] = *(const bf16x8*)(Cs + l * SP + (16 * ks + 8 * hi) * 2);
                f32x16 accd = f32x16{}, acco = f32x16{};
#pragma unroll
                for (int ks = 0; ks < 8; ++ks) acco = __builtin_amdgcn_mfma_f32_32x32x16_bf16(pvf[ks], cf[ks], acco, 0, 0, 0);
                const float al = acum[l];
                for (int sb = 0; sb <= lb; ++sb) {
                    f32x16 sT = f32x16{};
                    const unsigned char* brow = Bs + (32 * sb + pi32(r32)) * SP + 16 * hi;
#pragma unroll
                    for (int ks = 0; ks < 8; ++ks) { const bf16x8 bfr = *(const bf16x8*)(brow + 32 * ks); sT = __builtin_amdgcn_mfma_f32_32x32x16_bf16(bfr, cf[ks], sT, 0, 0, 0); }
                    unsigned wb[8];
#pragma unroll
                    for (int r = 0; r < 16; r += 2) {
                        const int s_a = 32 * sb + 16 * (r >> 3) + 8 * hi + (r & 7), s_b = s_a + 1;
                        float va, vb;
                        { const float e = __expf(fminf(al - acum[s_a], 0.f)) * dtv[s_a]; va = (s_a <= l) ? sT[r] * e : 0.f; if (s_a == l) va += dsk; }
                        { const float e = __expf(fminf(al - acum[s_b], 0.f)) * dtv[s_b]; vb = (s_b <= l) ? sT[r + 1] * e : 0.f; if (s_b == l) vb += dsk; }
                        wb[r >> 1] = pk2(va, vb); }
                    const u32x4 w0 = {wb[0], wb[1], wb[2], wb[3]}, w1 = {wb[4], wb[5], wb[6], wb[7]};
                    const bf16x8 x0 = *(const bf16x8*)(XT + r32 * SP + (32 * sb + 8 * hi) * 2), x1 = *(const bf16x8*)(XT + r32 * SP + (32 * sb + 16 + 8 * hi) * 2);
                    accd = __builtin_amdgcn_mfma_f32_32x32x16_bf16(x0, __builtin_bit_cast(bf16x8, w0), accd, 0, 0, 0);
                    accd = __builtin_amdgcn_mfma_f32_32x32x16_bf16(x1, __builtin_bit_cast(bf16x8, w1), accd, 0, 0, 0);
                }
                const float el = __expf(al); const size_t row = (size_t)(r0 + l); float ss = 0.f;
                const int colb = h * 64 + ph * 32 + 4 * hi;
#pragma unroll
                for (int rg = 0; rg < 4; ++rg) { const u32x2 zz = *(const u32x2*)(zb + row * 1024 + colb + 8 * rg);
                    const float g0 = (accd[4 * rg] + el * acco[4 * rg]) * silu(bf_lo(zz.x)), g1 = (accd[4 * rg + 1] + el * acco[4 * rg + 1]) * silu(bf_hi(zz.x));
                    const float g2 = (accd[4 * rg + 2] + el * acco[4 * rg + 2]) * silu(bf_lo(zz.y)), g3 = (accd[4 * rg + 3] + el * acco[4 * rg + 3]) * silu(bf_hi(zz.y));
                    ss += (g0 * g0 + g1 * g1) + (g2 * g2 + g3 * g3);
                    if (l < valid) { u32x2 w; w.x = pk2(g0, g1); w.y = pk2(g2, g3); *(u32x2*)(mix + row * 2048 + 1024 + colb + 8 * rg) = w; } }
                ss += __shfl_xor(ss, 32);
                if (hi == 0) rowss[(wave * 2 + ph) * 128 + l] = ss;
            }
            __builtin_amdgcn_s_waitcnt(0); asm volatile("" ::: "memory");
        }
        __threadfence(); __syncthreads();
        { const int l = tid >> 2, qd = tid & 3;
          if (l < valid) { float ss = 0.f;
#pragma unroll
              for (int k = 0; k < 16; ++k) ss += rowss[k * 128 + l];
              const float rstd = rsqrtf(ss * (1.f / 512.f) + EPS);
              bf16_t* rp = mix + (size_t)(r0 + l) * 2048 + 1024 + g * 512 + qd * 128; const float* gp = P.g_ssm + g * 512 + qd * 128;
#pragma unroll 4
              for (int k = 0; k < 16; ++k) { const u32x4 u = *(const u32x4*)(rp + 8 * k); const f32x4 g0 = *(const f32x4*)(gp + 8 * k), g1 = *(const f32x4*)(gp + 8 * k + 4);
                  u32x4 w; w.x = pk2(bf_lo(u.x) * rstd * g0.x, bf_hi(u.x) * rstd * g0.y); w.y = pk2(bf_lo(u.y) * rstd * g0.z, bf_hi(u.y) * rstd * g0.w);
                  w.z = pk2(bf_lo(u.z) * rstd * g1.x, bf_hi(u.z) * rstd * g1.y); w.w = pk2(bf_lo(u.w) * rstd * g1.z, bf_hi(u.w) * rstd * g1.w);
                  *(u32x4*)(rp + 8 * k) = w; } } }
    }
    __syncthreads();
}

namespace att {
constexpr int KP = 400, VP = 144, KT_BYTES = 64 * KP, VT_BYTES = 128 * VP, STG = KT_BYTES + VT_BYTES;
struct Stage { u32x4 k0, k1, kr, v0, v1; };
__device__ __forceinline__ void gload(Stage& s, const bf16_t* kb, const bf16_t* krb, const bf16_t* vt, int h, int kbase, int tid) {
    s.k0 = *(const u32x4*)(kb + (size_t)(kbase + (tid >> 4)) * 1024 + h * 128 + (tid & 15) * 8);
    s.k1 = *(const u32x4*)(kb + (size_t)(kbase + 32 + (tid >> 4)) * 1024 + h * 128 + (tid & 15) * 8);
    s.kr = *(const u32x4*)(krb + (size_t)(kbase + (tid >> 3)) * 64 + (tid & 7) * 8);
    s.v0 = *(const u32x4*)(vt + (size_t)(h * 128 + (tid >> 3)) * MP + kbase + (tid & 7) * 8);
    s.v1 = *(const u32x4*)(vt + (size_t)(h * 128 + 64 + (tid >> 3)) * MP + kbase + (tid & 7) * 8);
}
__device__ __forceinline__ void sstore(const Stage& s, unsigned char* buf, int tid) {
    unsigned char* Kt = buf; unsigned char* Vt = buf + KT_BYTES;
    *(u32x4*)(Kt + (tid >> 4) * KP + (tid & 15) * 16) = s.k0;
    *(u32x4*)(Kt + (32 + (tid >> 4)) * KP + (tid & 15) * 16) = s.k1;
    *(u32x4*)(Kt + (tid >> 3) * KP + 256 + (tid & 7) * 16) = s.kr;
    *(u32x4*)(Vt + (tid >> 3) * VP + (tid & 7) * 16) = s.v0;
    *(u32x4*)(Vt + (64 + (tid >> 3)) * VP + (tid & 7) * 16) = s.v1;
}
__device__ __forceinline__ void unit(const Params& P, unsigned char* lds, int h, int q0, int NT, int slo, int shi, int tid, int wave, int lane) {
    const bf16_t* qb = (const bf16_t*)(P.ws + WS_Q); const bf16_t* kb = (const bf16_t*)(P.ws + WS_K); const bf16_t* krb = (const bf16_t*)(P.ws + WS_KR);
    const bf16_t* vt = (const bf16_t*)(P.ws + WS_VT); bf16_t* mix = (bf16_t*)(P.ws + WS_MIX); const float2* rope = (const float2*)(P.ws + WS_ROPE);
    const int r32 = lane & 31, hi = lane >> 5;
    const int qrow = q0 + 32 * wave + r32;
    Stage sg; gload(sg, kb, krb, vt, h, 0, tid);
    bf16x8 qf[12];
    { const bf16_t* qp = qb + (size_t)qrow * QW + h * 192 + 8 * hi;
#pragma unroll
      for (int ks = 0; ks < 12; ++ks) qf[ks] = *(const bf16x8*)(qp + 16 * ks);
#pragma unroll
      for (int kk = 0; kk < 2; ++kk) { u32x4 a = __builtin_bit_cast(u32x4, qf[8 + kk]), b = __builtin_bit_cast(u32x4, qf[10 + kk]); u32x4 oa, ob;
          const float2* cs = rope + (size_t)qrow * 32 + 16 * kk + 8 * hi;
#pragma unroll
          for (int j = 0; j < 4; ++j) { const float2 c0 = cs[2 * j], c1 = cs[2 * j + 1];
              const float x1a = bf_lo(a[j]), x1b = bf_hi(a[j]), x2a = bf_lo(b[j]), x2b = bf_hi(b[j]);
              oa[j] = pk2(x1a * c0.x - x2a * c0.y, x1b * c1.x - x2b * c1.y); ob[j] = pk2(x2a * c0.x + x1a * c0.y, x2b * c1.x + x1b * c1.y); }
          qf[8 + kk] = __builtin_bit_cast(bf16x8, oa); qf[10 + kk] = __builtin_bit_cast(bf16x8, ob); } }
    f32x16 o[4];
#pragma unroll
    for (int d = 0; d < 4; ++d) o[d] = f32x16{};
    float mrun = -1e30f, lsum = 0.f;
    sstore(sg, lds, tid);
    __syncthreads();
    const int qmin_w = q0 + 32 * wave, qmax_w = qmin_w + 31;
    const int krow_off = pi32(r32) * KP + 16 * hi;
    for (int kt = 0; kt < NT; ++kt) {
        const int kbase = kt * 64;
        if (kt + 1 < NT) gload(sg, kb, krb, vt, h, kbase + 64, tid);
        const unsigned char* Kt = lds + (kt & 1) * STG; const unsigned char* Vt = Kt + KT_BYTES;
        if (kbase <= qmax_w) {
            f32x16 p0 = f32x16{}, p1 = f32x16{};
#pragma unroll
            for (int ks = 0; ks < 12; ++ks) { const bf16x8 a0 = *(const bf16x8*)(Kt + krow_off + 32 * ks), a1 = *(const bf16x8*)(Kt + 32 * KP + krow_off + 32 * ks);
                p0 = __builtin_amdgcn_mfma_f32_32x32x16_bf16(a0, qf[ks], p0, 0, 0, 0); p1 = __builtin_amdgcn_mfma_f32_32x32x16_bf16(a1, qf[ks], p1, 0, 0, 0); }
            if (kbase + 63 > qmin_w) {
#pragma unroll
                for (int r = 0; r < 16; ++r) { const int key = kbase + 16 * (r >> 3) + 8 * hi + (r & 7); if (key > qrow) p0[r] = -1e30f; if (key + 32 > qrow) p1[r] = -1e30f; } }
            float mx = fmaxf(p0[0], p1[0]);
#pragma unroll
            for (int r = 1; r < 16; ++r) mx = fmaxf(mx, fmaxf(p0[r], p1[r]));
            mx = fmaxf(mx, __shfl_xor(mx, 32));
            const float mnew = fmaxf(mrun, mx); const float alpha = __builtin_amdgcn_exp2f(mrun - mnew); mrun = mnew;
            float ps = 0.f;
#pragma unroll
            for (int r = 0; r < 16; ++r) { p0[r] = __builtin_amdgcn_exp2f(p0[r] - mnew); p1[r] = __builtin_amdgcn_exp2f(p1[r] - mnew); ps += p0[r] + p1[r]; }
            lsum = lsum * alpha + ps;
#pragma unroll
            for (int d = 0; d < 4; ++d) o[d] = o[d] * alpha;
            bf16x8 pb[4];
            { u32x4 t;
              t.x = pk2(p0[0], p0[1]); t.y = pk2(p0[2], p0[3]); t.z = pk2(p0[4], p0[5]); t.w = pk2(p0[6], p0[7]); pb[0] = __builtin_bit_cast(bf16x8, t);
              t.x = pk2(p0[8], p0[9]); t.y = pk2(p0[10], p0[11]); t.z = pk2(p0[12], p0[13]); t.w = pk2(p0[14], p0[15]); pb[1] = __builtin_bit_cast(bf16x8, t);
              t.x = pk2(p1[0], p1[1]); t.y = pk2(p1[2], p1[3]); t.z = pk2(p1[4], p1[5]); t.w = pk2(p1[6], p1[7]); pb[2] = __builtin_bit_cast(bf16x8, t);
              t.x = pk2(p1[8], p1[9]); t.y = pk2(p1[10], p1[11]); t.z = pk2(p1[12], p1[13]); t.w = pk2(p1[14], p1[15]); pb[3] = __builtin_bit_cast(bf16x8, t); }
#pragma unroll
            for (int d = 0; d < 4; ++d)
#pragma unroll
                for (int k2 = 0; k2 < 4; ++k2) { const bf16x8 va = *(const bf16x8*)(Vt + (32 * d + r32) * VP + (16 * k2 + 8 * hi) * 2);
                    o[d] = __builtin_amdgcn_mfma_f32_32x32x16_bf16(va, pb[k2], o[d], 0, 0, 0); }
        }
        if (kt + 1 < NT) sstore(sg, lds + ((kt + 1) & 1) * STG, tid);
        __syncthreads();
    }
    lsum += __shfl_xor(lsum, 32);
    const float inv = 1.f / lsum;
    if (qrow >= slo && qrow < shi) {
        bf16_t* op = mix + (size_t)qrow * 2048 + h * 128 + 4 * hi;
#pragma unroll
        for (int d = 0; d < 4; ++d)
#pragma unroll
            for (int rg = 0; rg < 4; ++rg) { u32x2 w; w.x = pk2(o[d][4 * rg] * inv, o[d][4 * rg + 1] * inv); w.y = pk2(o[d][4 * rg + 2] * inv, o[d][4 * rg + 3] * inv);
                *(u32x2*)(op + 32 * d + 8 * rg) = w; }
    }
}
__device__ __forceinline__ void blockunit(const Params& P, unsigned char* lds, int h, int b, int tid, int wave, int lane) {
    if (b == 0) unit(P, lds, h, 0, 1, 0, NMETA, tid, wave, lane);
    else { const int q0 = NMETA + 256 * (b - 1); unit(P, lds, h, q0, 4 * b + 1, q0, q0 + 256, tid, wave, lane); }
}
__device__ __forceinline__ void phase(const Params& P, unsigned char* lds, int tid, int wave, int lane) {
    for (int w = blockIdx.x; w < 264; w += gridDim.x) {
        if (w < 256) { const int h = w & 7, j = w >> 3; blockunit(P, lds, h, 64 - j, tid, wave, lane); blockunit(P, lds, h, j + 1, tid, wave, lane); }
        else blockunit(P, lds, w - 256, 0, tid, wave, lane);
    }
}
}

__device__ __forceinline__ void phase_rows1(const Params& P, int gw, int NGW, int lane) {
    const float* mixo = (const float*)(P.ws + WS_MIXO); bf16_t* hn2 = (bf16_t*)(P.ws + WS_HN2);
    for (int m = gw; m < SEQ; m += NGW) {
        const f32x4* mr = (const f32x4*)(mixo + (size_t)m * DM) + lane; const f32x4* xr = (const f32x4*)(P.x + (size_t)m * DM) + lane;
        const f32x4* g1 = (const f32x4*)P.g_mix_post + lane; const f32x4* g2 = (const f32x4*)P.g_mlp_pre + lane;
        f32x4 v[4]; float s = 0.f;
#pragma unroll
        for (int j = 0; j < 4; ++j) { v[j] = mr[64 * j]; s += (v[j].x * v[j].x + v[j].y * v[j].y) + (v[j].z * v[j].z + v[j].w * v[j].w); }
        const float r1 = rsqrtf(wave_sum(s) * (1.f / DM) + EPS); float s2 = 0.f;
#pragma unroll
        for (int j = 0; j < 4; ++j) { v[j] = xr[64 * j] + v[j] * r1 * g1[64 * j]; s2 += (v[j].x * v[j].x + v[j].y * v[j].y) + (v[j].z * v[j].z + v[j].w * v[j].w); }
        const float r2 = rsqrtf(wave_sum(s2) * (1.f / DM) + EPS);
        f32x4* orow = (f32x4*)(P.out + (size_t)m * DM) + lane; unsigned long long* o8 = (unsigned long long*)(hn2 + (size_t)m * DM) + lane;
#pragma unroll
        for (int j = 0; j < 4; ++j) { orow[64 * j] = v[j]; const f32x4 g = g2[64 * j];
            o8[64 * j] = (unsigned long long)pk2(v[j].x * r2 * g.x, v[j].y * r2 * g.y) | ((unsigned long long)pk2(v[j].z * r2 * g.z, v[j].w * r2 * g.w) << 32); }
    }
}
__device__ __forceinline__ void phase_rows2(const Params& P, int gw, int NGW, int lane) {
    const float* f = (const float*)(P.ws + WS_F);
    for (int m = gw; m < SEQ; m += NGW) {
        const f32x4* fr = (const f32x4*)(f + (size_t)m * DM) + lane; f32x4* orow = (f32x4*)(P.out + (size_t)m * DM) + lane; const f32x4* g1 = (const f32x4*)P.g_mlp_post + lane;
        f32x4 v[4]; float s = 0.f;
#pragma unroll
        for (int j = 0; j < 4; ++j) { v[j] = fr[64 * j]; s += (v[j].x * v[j].x + v[j].y * v[j].y) + (v[j].z * v[j].z + v[j].w * v[j].w); }
        const float r1 = rsqrtf(wave_sum(s) * (1.f / DM) + EPS);
#pragma unroll
        for (int j = 0; j < 4; ++j) orow[64 * j] = orow[64 * j] + v[j] * r1 * g1[64 * j];
    }
}

__global__ void __launch_bounds__(512) hymba_fwd(Params P) {
    extern __shared__ __attribute__((aligned(16))) unsigned char lds[];
    const int tid = threadIdx.x, lane = tid & 63, wave = __builtin_amdgcn_readfirstlane(tid >> 6);
    const int G = gridDim.x, gw = blockIdx.x * 8 + wave, NGW = G * 8;
    PG8_LAS unsigned char* lds3 = (PG8_LAS unsigned char*)lds;
    unsigned char* ws = P.ws;
    const int lo = P.ph_lo, hi = P.ph_hi;
#define IN(k) (lo <= (k) && (k) < hi)
#define SEAM(k) do { if (IN(k) && IN((k) + 1)) { cg::this_grid().sync(); } } while (0)
    typedef pg8::bf16_t bt;
    if (IN(0)) { phase0(P, lds, gw, NGW, wave, lane); } SEAM(0);
    if (IN(1)) {
        pg8::Gemm g{(const bt*)(ws + WS_HN), (const bt*)(ws + WS_WIN), MP, INWP, 1024, 1024, 1024}; pg8::StaticOrder S; S.init(MP, INWP, G, (int)blockIdx.x);
        pg8::EpiInProj E{(bt*)(ws + WS_LAT), (bt*)(ws + WS_Z), (bt*)(ws + WS_XBC), (float*)(ws + WS_DT), P.dt_bias};
        pg8::gemm_phase<pg8::EpiInProj, pg8::StaticOrder, true, true>(lds3, g, S, E);
    } SEAM(1);
    if (IN(2)) { phase_latn(P, gw, NGW, lane); phase_ssd_states(P, lds, tid, wave, lane); } SEAM(2);
    if (IN(3)) { phase_scan(P, tid); } SEAM(3);
    if (IN(4)) { phase_ssd_y(P, lds, tid, wave, lane); } SEAM(4);
    if (IN(5)) {
        { pg8::Gemm g{(const bt*)(ws + WS_LAT), (const bt*)(ws + WS_WQ), MP, QW, 384, LATW, 384}; pg8::StaticOrder S; S.init(MP, QW, G, (int)blockIdx.x);
          pg8::EpiBf16<0> E{(bt*)(ws + WS_Q), QW, QSCALE}; pg8::gemm_phase<pg8::EpiBf16<0>, pg8::StaticOrder, true, true>(lds3, g, S, E); }
        __syncthreads();
        { pg8::Gemm g{(const bt*)(ws + WS_LAT) + 384, (const bt*)(ws + WS_WK), MP, 1024, 256, LATW, 256}; pg8::StaticOrder S; S.init(MP, 1024, G, (int)blockIdx.x);
          pg8::EpiBf16<0> E{(bt*)(ws + WS_K), 1024, 1.f}; pg8::gemm_phase<pg8::EpiBf16<0>, pg8::StaticOrder, true, true>(lds3, g, S, E); }
        __syncthreads();
        { pg8::Gemm g{(const bt*)(ws + WS_WV), (const bt*)(ws + WS_LAT) + 384, 1024, MP, 256, 256, LATW}; pg8::StaticOrder S; S.init(1024, MP, G, (int)blockIdx.x);
          pg8::EpiBf16<0> E{(bt*)(ws + WS_VT), MP, 1.f}; pg8::gemm_phase<pg8::EpiBf16<0>, pg8::StaticOrder, true, true>(lds3, g, S, E); }
    } SEAM(5);
    if (IN(6)) { att::phase(P, lds, tid, wave, lane); } SEAM(6);
    if (IN(7)) {
        pg8::Gemm g{(const bt*)(ws + WS_MIX) + (size_t)NMETA * 2048, (const bt*)(ws + WS_WOUT), SEQ, 1024, 2048, 2048, 2048}; pg8::StaticOrder S; S.init(SEQ, 1024, G, (int)blockIdx.x);
        pg8::EpiF32 E{(float*)(ws + WS_MIXO), 1024}; pg8::gemm_phase<pg8::EpiF32, pg8::StaticOrder, true, true>(lds3, g, S, E);
    } SEAM(7);
    if (IN(8)) { phase_rows1(P, gw, NGW, lane); } SEAM(8);
    if (IN(9)) {
        pg8::Gemm g{(const bt*)(ws + WS_HN2), (const bt*)(ws + WS_WUP), SEQ, DFF, 1024, 1024, 1024}; pg8::StaticOrder S; S.init(SEQ, DFF, G, (int)blockIdx.x);
        pg8::EpiBf16<2> E{(bt*)(ws + WS_FF), DFF, 1.f}; pg8::gemm_phase<pg8::EpiBf16<2>, pg8::StaticOrder, true, true>(lds3, g, S, E);
    } SEAM(9);
    if (IN(10)) {
        pg8::Gemm g{(const bt*)(ws + WS_FF), (const bt*)(ws + WS_WDN), SEQ, 1024, DFF, DFF, DFF}; pg8::StaticOrder S; S.init(SEQ, 1024, G, (int)blockIdx.x);
        pg8::EpiF32 E{(float*)(ws + WS_F), 1024}; pg8::gemm_phase<pg8::EpiF32, pg8::StaticOrder, true, true>(lds3, g, S, E);
    } SEAM(10);
    if (IN(11)) { phase_rows2(P, gw, NGW, lane); }
#undef IN
#undef SEAM
}

extern "C" void kernel_launch(void* const* d_in, const int* in_sizes, int n_in, void* d_out, int out_size, void* d_ws, size_t ws_size, hipStream_t stream) {
    static int grid = 0;
    if (grid == 0) {
        int dev = 0, cus = 0, per_cu = 0;
        hipGetDevice(&dev); hipDeviceGetAttribute(&cus, hipDeviceAttributeMultiprocessorCount, dev);
        if (hipFuncSetAttribute((const void*)hymba_fwd, hipFuncAttributeMaxDynamicSharedMemorySize, LDS_BYTES) != hipSuccess) { fprintf(stderr, "hipFuncSetAttribute failed\n"); }
        if (hipOccupancyMaxActiveBlocksPerMultiprocessor(&per_cu, (const void*)hymba_fwd, 512, LDS_BYTES) != hipSuccess || per_cu < 1) { fprintf(stderr, "occupancy query: %d\n", per_cu); per_cu = 1; }
        (void)hipGetLastError();
        grid = cus * 1;
        if (ws_size < 256 * MiB) { fprintf(stderr, "workspace too small: %zu\n", ws_size); grid = -1; }
    }
    if (grid < 0) return;
    Params p{};
    const float** pp = (const float**)&p;
    for (int i = 0; i < 20; ++i) pp[i] = (const float*)d_in[i];
    p.out = (float*)d_out; p.ws = (unsigned char*)d_ws;
    for (int j = 0; j < 32; ++j) p.invf[j] = (float)pow(10000.0, -(double)(2 * j) / 64.0);
#if ONE_LAUNCH
    p.ph_lo = 0; p.ph_hi = NPHASE;
    void* args[] = {&p};
    hipError_t e = hipLaunchCooperativeKernel((const void*)hymba_fwd, dim3(grid), dim3(512), args, LDS_BYTES, stream);
    if (e != hipSuccess) fprintf(stderr, "cooperative launch failed: %s (grid %d)\n", hipGetErrorString(e), grid);
#else
    for (int ph = 0; ph < NPHASE; ++ph) { p.ph_lo = ph; p.ph_hi = ph + 1; hipLaunchKernelGGL(hymba_fwd, dim3(grid), dim3(512), LDS_BYTES, stream, p); }
#endif
}
```

```cpp
#include <hip/hip_runtime.h>
#include <hip/hip_cooperative_groups.h>
#include <cstdio>
#include <cstdint>
#include <cmath>
namespace cg = cooperative_groups;

#ifndef ONE_LAUNCH
#define ONE_LAUNCH 1
#endif

namespace pg8 {
#define PG8_LAS __attribute__((address_space(3)))
typedef unsigned short bf16_t;
typedef short bf16x8 __attribute__((ext_vector_type(8)));
typedef float f32x4 __attribute__((ext_vector_type(4)));
typedef unsigned u32x4 __attribute__((ext_vector_type(4)));
constexpr int BM = 256, BK = 64, HALF = 128, HTB = HALF * BK * 2, STAGE_BYTES = 8 * HTB, NXCD = 8, WGM = 8;

__host__ __device__ __forceinline__ int lds_byte(int r, int c) { const int st = (r >> 4) * 2 + (c >> 5), rr = r & 15, cc = c & 31, ob = rr * 64 + cc * 2; return st * 1024 + (ob ^ (((ob >> 9) & 1) << 5)); }
__host__ __device__ __forceinline__ void stage_rc(int b, int& R, int& C) { const int st = b / 1024, sb = b % 1024, swz = sb ^ (((sb >> 9) & 1) << 5); R = (st >> 1) * 16 + swz / 64; C = (st & 1) * 32 + (swz % 64) / 2; }
__host__ __device__ __forceinline__ int perm32(int rho) { const int n = rho >> 4, i = rho & 15; return 8 * (i >> 2) + 4 * n + (i & 3); }

struct Unit { int pm, pn; };
struct Gemm { const bf16_t* A; const bf16_t* Bt; int M, N, K, lda, ldb; };

struct StaticOrder {
    int nM, nN, nwg, G, c;
    __host__ __device__ void init(int M, int N, int G_, int c_) { nM = M / BM; nN = N / BM; nwg = nM * nN; G = G_; c = c_; }
    __host__ __device__ bool next(int i, Unit& u) const {
        const long L = (long)i * G + c; if (L >= nwg) return false;
        int wgid = (int)L; { const int q = nwg / NXCD, r = nwg % NXCD, xcd = wgid % NXCD, off = wgid / NXCD; wgid = (xcd < r ? xcd * (q + 1) : r * (q + 1) + (xcd - r) * q) + off; }
        const int nig = WGM * nN, gid = wgid / nig, fm = gid * WGM, gsz = (nM - fm) < WGM ? (nM - fm) : WGM;
        u.pm = fm + ((wgid % nig) % gsz); u.pn = (wgid % nig) / gsz; return true;
    }
    __device__ __forceinline__ void a_ready(const Unit&) const {}
    __device__ __forceinline__ void done(const Unit&) const {}
};

typedef float f32x2_t __attribute__((ext_vector_type(2))); typedef __bf16 bf16x2_t __attribute__((ext_vector_type(2)));
__device__ __forceinline__ unsigned cvt_pk_bf16(float lo, float hi) { f32x2_t v = {lo, hi}; bf16x2_t b = __builtin_convertvector(v, bf16x2_t); return __builtin_bit_cast(unsigned, b); }

template <int ACT  > struct EpiBf16 {
    static constexpr bool PERM = true, AFTER_DRAIN = false;
    bf16_t* O; int ldc; float scale;
    __device__ __forceinline__ void operator()(const f32x4 (&acc)[2][2][4][2], const Unit& u, int wr, int wc, int fr, int fq) const {
        const int row0 = u.pm * BM + wr * 64 + fr; const int col0 = u.pn * BM + wc * 32 + 8 * fq;
#pragma unroll
        for (int ai = 0; ai < 2; ++ai)
#pragma unroll
            for (int m = 0; m < 4; ++m) { bf16_t* rowp = O + (size_t)(row0 + ai * HALF + m * 16) * ldc + col0;
#pragma unroll
                for (int bj = 0; bj < 2; ++bj) { f32x4 v0 = acc[ai][bj][m][0], v1 = acc[ai][bj][m][1];
                    if (ACT == 2) {
#pragma unroll
                        for (int i = 0; i < 4; ++i) { float a = v0[i] > 0.f ? v0[i] : 0.f; v0[i] = a * a; float b = v1[i] > 0.f ? v1[i] : 0.f; v1[i] = b * b; } }
                    v0 = v0 * scale; v1 = v1 * scale; u32x4 w; w.x = cvt_pk_bf16(v0[0], v0[1]); w.y = cvt_pk_bf16(v0[2], v0[3]); w.z = cvt_pk_bf16(v1[0], v1[1]); w.w = cvt_pk_bf16(v1[2], v1[3]);
                    *(u32x4*)(rowp + bj * HALF) = w; } }
    }
};
struct EpiF32 {
    static constexpr bool PERM = true, AFTER_DRAIN = false;
    float* O; int ldc;
    __device__ __forceinline__ void operator()(const f32x4 (&acc)[2][2][4][2], const Unit& u, int wr, int wc, int fr, int fq) const {
        const int row0 = u.pm * BM + wr * 64 + fr; const int col0 = u.pn * BM + wc * 32 + 8 * fq;
#pragma unroll
        for (int ai = 0; ai < 2; ++ai)
#pragma unroll
            for (int m = 0; m < 4; ++m) { float* rowp = O + (size_t)(row0 + ai * HALF + m * 16) * ldc + col0;
#pragma unroll
                for (int bj = 0; bj < 2; ++bj) { *(f32x4*)(rowp + bj * HALF) = acc[ai][bj][m][0]; *(f32x4*)(rowp + bj * HALF + 4) = acc[ai][bj][m][1]; } }
    }
};
struct EpiInProj {
    static constexpr bool PERM = true, AFTER_DRAIN = false;
    bf16_t* lat; bf16_t* z; bf16_t* xbc; float* dt; const float* dt_bias;
    __device__ __forceinline__ void operator()(const f32x4 (&acc)[2][2][4][2], const Unit& u, int wr, int wc, int fr, int fq) const {
        const int row0 = u.pm * BM + wr * 64 + fr; const int colb = u.pn * BM + wc * 32 + 8 * fq;
#pragma unroll
        for (int ai = 0; ai < 2; ++ai)
#pragma unroll
            for (int m = 0; m < 4; ++m) { const size_t row = (size_t)(row0 + ai * HALF + m * 16);
#pragma unroll
                for (int bj = 0; bj < 2; ++bj) { const int col = colb + bj * HALF; const f32x4 v0 = acc[ai][bj][m][0], v1 = acc[ai][bj][m][1];
                    if (col < 3264) {
                        u32x4 w; w.x = cvt_pk_bf16(v0[0], v0[1]); w.y = cvt_pk_bf16(v0[2], v0[3]); w.z = cvt_pk_bf16(v1[0], v1[1]); w.w = cvt_pk_bf16(v1[2], v1[3]);
                        bf16_t* p;
                        if (col < 704) p = lat + row * 704 + col; else if (col < 1728) p = z + row * 1024 + (col - 704); else p = xbc + row * 1536 + (col - 1728);
                        *(u32x4*)p = w;
                    } else if (col < 3280) {
                        const int c0 = col - 3264; f32x4 o0, o1;
#pragma unroll
                        for (int i = 0; i < 4; ++i) { float a = v0[i] + dt_bias[c0 + i]; o0[i] = fmaxf(a, 0.f) + log1pf(__expf(-fabsf(a))); float b = v1[i] + dt_bias[c0 + 4 + i]; o1[i] = fmaxf(b, 0.f) + log1pf(__expf(-fabsf(b))); }
                        *(f32x4*)(dt + row * 16 + c0) = o0; *(f32x4*)(dt + row * 16 + c0 + 4) = o1;
                    } } }
    }
};

template <class Epi, class Sched, bool ALIGN_EPI = false, bool SP2 = false>
__device__ __forceinline__ void gemm_phase(PG8_LAS unsigned char* lds, const Gemm g, const Sched& S, const Epi& E) {
    int tid = threadIdx.x; asm volatile("" : "+v"(tid));
    const int wid = __builtin_amdgcn_readfirstlane(tid >> 6), lane = tid & 63, wr = wid >> 2, wc = wid & 3, fr = lane & 15, fq = lane >> 4;
    const int K = g.K, nt = K / BK;
    unsigned voffA[2], voffB[2];
#pragma unroll
    for (int i = 0; i < 2; ++i) { int R, C; stage_rc(tid * 16 + i * 8192, R, C); const int Rb = Epi::PERM ? ((R & ~31) + perm32(R & 31)) : R;
        voffA[i] = (unsigned)(R * g.lda + C) * 2u; voffB[i] = (unsigned)(Rb * g.ldb + C) * 2u; }
    const size_t kstep = (size_t)(BK * 2);
    const size_t hstepA = (size_t)HALF * g.lda * 2, hstepB = (size_t)HALF * g.ldb * 2;
    const size_t tstepA = 2 * hstepA, tstepB = 2 * hstepB;
    const unsigned ldsw = (unsigned)wid * 1024u;
    const int aoff = lds_byte(wr * 64 + fr, fq * 8), boff = lds_byte(wc * 32 + fr, fq * 8);
#define PG8_SA(b, h) (((b) * 2 + (h)) * HTB)
#define PG8_SB(b, h) ((4 + (b) * 2 + (h)) * HTB)
#define PG8_STAGE(bufoff, gbase, voff) do { _Pragma("unroll") for (int _i = 0; _i < 2; ++_i) \
        __builtin_amdgcn_global_load_lds((const unsigned*)((const char*)(gbase) + (voff)[_i]), (PG8_LAS unsigned*)(lds + (bufoff) + ldsw + _i * 8192), 16, 0, 0); } while (0)
#define PG8_LDA(dst, b, h) do { _Pragma("unroll") for (int m = 0; m < 4; ++m) _Pragma("unroll") for (int k = 0; k < 2; ++k) dst[m][k] = *(const PG8_LAS bf16x8*)(lds + PG8_SA(b, h) + aoff + m * 2048 + k * 1024); } while (0)
#define PG8_LDB(dst, b, h) do { _Pragma("unroll") for (int n = 0; n < 2; ++n) _Pragma("unroll") for (int k = 0; k < 2; ++k) dst[n][k] = *(const PG8_LAS bf16x8*)(lds + PG8_SB(b, h) + boff + n * 2048 + k * 1024); } while (0)
#define PG8_MMA(ai, bj, At, Bt) do { __builtin_amdgcn_s_setprio(1); _Pragma("unroll") for (int m = 0; m < 4; ++m) _Pragma("unroll") for (int n = 0; n < 2; ++n) _Pragma("unroll") for (int k = 0; k < 2; ++k) \
        acc[ai][bj][m][n] = __builtin_amdgcn_mfma_f32_16x16x32_bf16(Bt[n][k], At[m][k], acc[ai][bj][m][n], 0, 0, 0); __builtin_amdgcn_s_setprio(0); } while (0)
#define PG8_WAIT_V(n) asm volatile("s_waitcnt vmcnt(" #n ")" ::: "memory")
#define PG8_WAIT_L(n) asm volatile("s_waitcnt lgkmcnt(" #n ")" ::: "memory")
#define PG8_BAR __builtin_amdgcn_s_barrier()
#define PG8_SCHED __builtin_amdgcn_sched_barrier(0)
    Unit cur, nxt; int ui = 0;
    if (!S.next(0, cur)) return;
    f32x4 acc[2][2][4][2];
#pragma unroll
    for (int a = 0; a < 2; ++a)
#pragma unroll
        for (int b = 0; b < 2; ++b)
#pragma unroll
            for (int m = 0; m < 4; ++m)
#pragma unroll
                for (int n = 0; n < 2; ++n) acc[a][b][m][n] = (f32x4){0.f, 0.f, 0.f, 0.f};
    bf16x8 At[4][2], B0[2][2], B1[2][2];
    const char* cA = (const char*)g.A + (size_t)cur.pm * tstepA; const char* cB = (const char*)g.Bt + (size_t)cur.pn * tstepB;
    S.a_ready(cur);
    if constexpr (SP2) {
        PG8_STAGE(PG8_SB(0, 0), cB, voffB); PG8_STAGE(PG8_SB(0, 1), cB + hstepB, voffB); PG8_STAGE(PG8_SA(0, 0), cA, voffA); PG8_STAGE(PG8_SA(0, 1), cA + hstepA, voffA);
        if (wr == 1) PG8_BAR;
        PG8_WAIT_V(2); PG8_BAR;
        PG8_STAGE(PG8_SB(1, 0), cB + kstep, voffB); PG8_STAGE(PG8_SA(1, 0), cA + kstep, voffA); PG8_STAGE(PG8_SB(1, 1), cB + hstepB + kstep, voffB);
        PG8_WAIT_V(6); PG8_BAR;
    } else {
        PG8_STAGE(PG8_SB(0, 0), cB, voffB); PG8_STAGE(PG8_SA(0, 0), cA, voffA); PG8_STAGE(PG8_SB(0, 1), cB + hstepB, voffB); PG8_STAGE(PG8_SA(0, 1), cA + hstepA, voffA);
        if (wr == 1) PG8_BAR;
        PG8_WAIT_V(4); PG8_BAR;
        PG8_STAGE(PG8_SB(1, 0), cB + kstep, voffB); PG8_STAGE(PG8_SA(1, 0), cA + kstep, voffA); PG8_STAGE(PG8_SB(1, 1), cB + hstepB + kstep, voffB);
        PG8_WAIT_V(6); PG8_BAR;
    }
    for (;;) {
        const bool has_next = S.next(ui + 1, nxt);
        const char* nA = has_next ? (const char*)g.A + (size_t)nxt.pm * tstepA : cA; const char* nB = has_next ? (const char*)g.Bt + (size_t)nxt.pn * tstepB : cB;
        for (int t = 0; t < nt; t += 2) {
            const bool last = (t == nt - 2);
            const char* a1 = cA + (size_t)(t + 1) * kstep;
            const char* a2 = last ? nA : cA + (size_t)(t + 2) * kstep; const char* b2 = last ? nB : cB + (size_t)(t + 2) * kstep;
            const char* a3 = a2 + kstep; const char* b3 = b2 + kstep;
            if (last && has_next) S.a_ready(nxt);
            if constexpr (SP2) {
            PG8_LDB(B0, 0, 0); PG8_LDB(B1, 0, 1); PG8_SCHED; PG8_LDA(At, 0, 0); PG8_STAGE(PG8_SA(1, 1), a1 + hstepA, voffA);
            PG8_WAIT_V(8); PG8_WAIT_L(0); PG8_BAR; PG8_MMA(0, 0, At, B0); PG8_MMA(0, 1, At, B1); PG8_BAR; PG8_SCHED;
            PG8_LDA(At, 0, 1); PG8_STAGE(PG8_SB(0, 0), b2, voffB); PG8_STAGE(PG8_SB(0, 1), b2 + hstepB, voffB); PG8_STAGE(PG8_SA(0, 0), a2, voffA);
            PG8_WAIT_V(8); PG8_WAIT_L(0); PG8_BAR; PG8_MMA(1, 0, At, B0); PG8_MMA(1, 1, At, B1); PG8_BAR; PG8_SCHED;
            PG8_LDB(B0, 1, 0); PG8_LDB(B1, 1, 1); PG8_SCHED; PG8_LDA(At, 1, 0); PG8_STAGE(PG8_SA(0, 1), a2 + hstepA, voffA);
            PG8_WAIT_V(8); PG8_WAIT_L(0); PG8_BAR; PG8_MMA(0, 0, At, B0); PG8_MMA(0, 1, At, B1); PG8_BAR; PG8_SCHED;
            PG8_LDA(At, 1, 1); PG8_STAGE(PG8_SB(1, 0), b3, voffB); PG8_STAGE(PG8_SB(1, 1), b3 + hstepB, voffB); PG8_STAGE(PG8_SA(1, 0), a3, voffA);
            PG8_WAIT_V(8); PG8_WAIT_L(0); PG8_BAR; PG8_MMA(1, 0, At, B0); PG8_MMA(1, 1, At, B1); PG8_BAR; PG8_SCHED;
            } else {
            PG8_LDB(B0, 0, 0); PG8_SCHED; PG8_LDA(At, 0, 0); PG8_STAGE(PG8_SA(1, 1), a1 + hstepA, voffA);
            PG8_WAIT_L(8); PG8_BAR; PG8_WAIT_L(0); PG8_MMA(0, 0, At, B0); PG8_BAR; PG8_SCHED;
            PG8_LDB(B1, 0, 1); PG8_STAGE(PG8_SB(0, 0), b2, voffB);
            PG8_BAR; PG8_WAIT_L(0); PG8_MMA(0, 1, At, B1); PG8_BAR;
            PG8_LDA(At, 0, 1); PG8_STAGE(PG8_SA(0, 0), a2, voffA);
            PG8_BAR; PG8_WAIT_L(0); PG8_MMA(1, 0, At, B0); PG8_BAR; PG8_SCHED;
            PG8_STAGE(PG8_SB(0, 1), b2 + hstepB, voffB);
            PG8_WAIT_V(6); PG8_BAR; PG8_MMA(1, 1, At, B1); PG8_BAR;
            PG8_LDB(B0, 1, 0); PG8_SCHED; PG8_LDA(At, 1, 0); PG8_STAGE(PG8_SA(0, 1), a2 + hstepA, voffA);
            PG8_WAIT_L(8); PG8_BAR; PG8_WAIT_L(0); PG8_MMA(0, 0, At, B0); PG8_BAR; PG8_SCHED;
            PG8_LDB(B1, 1, 1); PG8_STAGE(PG8_SB(1, 0), b3, voffB);
            PG8_BAR; PG8_WAIT_L(0); PG8_MMA(0, 1, At, B1); PG8_BAR;
            PG8_LDA(At, 1, 1); PG8_STAGE(PG8_SA(1, 0), a3, voffA);
            PG8_BAR; PG8_WAIT_L(0); PG8_MMA(1, 0, At, B0); PG8_BAR; PG8_SCHED;
            PG8_STAGE(PG8_SB(1, 1), b3 + hstepB, voffB);
            PG8_WAIT_V(6); PG8_BAR; PG8_MMA(1, 1, At, B1); PG8_BAR;
            }
        }
        if constexpr (ALIGN_EPI) { if (wr == 0) PG8_BAR; }
        if constexpr (!Epi::AFTER_DRAIN) { E(acc, cur, wr, wc, fr, fq); S.done(cur); }
        if (!has_next) break;
#pragma unroll
        for (int a = 0; a < 2; ++a)
#pragma unroll
            for (int b = 0; b < 2; ++b)
#pragma unroll
                for (int m = 0; m < 4; ++m)
#pragma unroll
                    for (int n = 0; n < 2; ++n) acc[a][b][m][n] = (f32x4){0.f, 0.f, 0.f, 0.f};
        cur = nxt; cA = nA; cB = nB; ++ui;
        if constexpr (ALIGN_EPI) { if (wr == 1) PG8_BAR; }
    }
    PG8_WAIT_V(0);
    if constexpr (!ALIGN_EPI) { if (wr == 0) PG8_BAR; }
    PG8_BAR;
#undef PG8_SA
#undef PG8_SB
#undef PG8_STAGE
#undef PG8_LDA
#undef PG8_LDB
#undef PG8_MMA
#undef PG8_WAIT_V
#undef PG8_WAIT_L
#undef PG8_BAR
#undef PG8_SCHED
}
}

typedef unsigned short bf16_t;
typedef short bf16x8 __attribute__((ext_vector_type(8)));
typedef float f32x16 __attribute__((ext_vector_type(16)));
typedef float f32x4 __attribute__((ext_vector_type(4)));
typedef unsigned u32x4 __attribute__((ext_vector_type(4)));
typedef unsigned u32x2 __attribute__((ext_vector_type(2)));

constexpr int DM = 1024, SEQ = 16384, NMETA = 16, L = SEQ + NMETA  , MP = 16640  ;
constexpr int INW = 3280, INWP = 3328, LATW = 704, QW = 1536, XBCW = 1536, DFF = 4096;
constexpr int NCH = 129;
constexpr float EPS = 1e-6f;
constexpr float QSCALE = 0.07216878364870322f * 1.4426950408889634f;
constexpr size_t MiB = 1u << 20;
constexpr size_t WS_WIN = 1 * MiB, WS_WQ = WS_WIN + (size_t)INWP * 1024 * 2, WS_WK = WS_WQ + (size_t)1536 * 384 * 2, WS_WV = WS_WK + (size_t)1024 * 256 * 2;
constexpr size_t WS_WOUT = 10 * MiB, WS_WUP = 14 * MiB, WS_WDN = 22 * MiB;
constexpr size_t WS_DT = 30 * MiB, WS_CDEC = 31 * MiB + 512 * 1024, WS_ROPE = 32 * MiB;
constexpr size_t WS_MIX = 37 * MiB;
constexpr size_t WS_HN = 37 * MiB;
constexpr size_t WS_LAT = 102 * MiB;
constexpr size_t WS_Z = 124 * MiB + 512 * 1024;
constexpr size_t WS_XBC = 157 * MiB;
constexpr size_t WS_ST = 205 * MiB + 768 * 1024;
constexpr size_t WS_KR = 253 * MiB;
constexpr size_t WS_BCONV = 238 * MiB + 512 * 1024;
static_assert(WS_BCONV + (size_t)MP * 256 * 2 <= WS_KR, "bconv");
constexpr size_t WS_Q = WS_Z;
constexpr size_t WS_K = 173 * MiB + 256 * 1024;
constexpr size_t WS_VT = 205 * MiB + 768 * 1024;
constexpr size_t WS_MIXO = 102 * MiB;
constexpr size_t WS_HN2 = 224 * MiB;
constexpr size_t WS_FF = 37 * MiB;
constexpr size_t WS_F = 165 * MiB;
static_assert(WS_WV + (size_t)1024 * 256 * 2 <= WS_WOUT, "w");
static_assert(WS_ROPE + (size_t)L * 32 * 8 <= WS_MIX, "rope");
static_assert(WS_MIX + (size_t)MP * 2048 * 2 <= WS_LAT, "mix");
static_assert(WS_LAT + (size_t)MP * 704 * 2 <= WS_Z, "lat");
static_assert(WS_Z + (size_t)MP * 1024 * 2 <= WS_XBC, "z");
static_assert(WS_XBC + (size_t)MP * 1536 * 2 <= WS_ST, "xbc");
static_assert(WS_ST + (size_t)NCH * 131072 * 2 <= WS_KR, "st");
static_assert(WS_KR + (size_t)MP * 64 * 2 <= 256 * MiB, "kr");
static_assert(WS_Q + (size_t)MP * 1536 * 2 <= WS_K && WS_K + (size_t)MP * 1024 * 2 <= WS_VT && WS_VT + (size_t)1024 * MP * 2 <= WS_KR, "qkv");
static_assert(WS_MIXO + (size_t)SEQ * 1024 * 4 <= WS_HN2 && WS_FF + (size_t)SEQ * 4096 * 2 <= WS_F && WS_F + (size_t)SEQ * 1024 * 4 <= 256 * MiB, "tail");

constexpr int LDS_BYTES = 160 * 1024;
constexpr int NPHASE = 12;

struct Params {
    const float *x, *meta, *g_mix_pre, *w_in, *g_qa, *w_q_up, *g_kva, *w_kv_up, *conv_w, *conv_b, *dt_bias, *a_log, *d_skip, *g_ssm, *w_out, *g_mix_post, *g_mlp_pre, *w_up, *w_dn, *g_mlp_post;
    float* out; unsigned char* ws;
    float invf[32];
    int ph_lo, ph_hi;
};

__device__ __forceinline__ float bf_lo(unsigned u) { return __uint_as_float(u << 16); }
__device__ __forceinline__ float bf_hi(unsigned u) { return __uint_as_float(u & 0xffff0000u); }
__device__ __forceinline__ float bf2f(bf16_t b) { return __uint_as_float(((unsigned)b) << 16); }
__device__ __forceinline__ unsigned pk2(float lo, float hi) { return pg8::cvt_pk_bf16(lo, hi); }
__device__ __forceinline__ bf16_t f2bf(float f) { return (bf16_t)(pk2(f, 0.f) & 0xffffu); }
__device__ __forceinline__ float wave_sum(float v) {
#pragma unroll
    for (int o = 1; o < 64; o <<= 1) v += __shfl_xor(v, o);
    return v;
}
__device__ __forceinline__ float silu(float v) { return v * __builtin_amdgcn_rcpf(1.f + __expf(-v)); }

__device__ __forceinline__ void p0_transpose_item(const float* W, int K, int ldsrc, bf16_t* WT, float* scr, int k0, int n0, int scol0, int nvalid, int lane) {
    const bool ok = (n0 + (lane & 31)) < nvalid;
#pragma unroll 8
    for (int i = 0; i < 32; ++i) { const int kk = 2 * i + (lane >> 5); scr[kk * 33 + (lane & 31)] = ok ? W[(size_t)(k0 + kk) * ldsrc + scol0 + (lane & 31)] : 0.f; }
    __builtin_amdgcn_s_waitcnt(0); asm volatile("" ::: "memory");
    const int c = lane & 7;
#pragma unroll
    for (int j = 0; j < 4; ++j) { const int n = (lane >> 3) + 8 * j; const float* s = scr + (8 * c) * 33 + n;
        u32x4 o; o.x = pk2(s[0 * 33], s[1 * 33]); o.y = pk2(s[2 * 33], s[3 * 33]); o.z = pk2(s[4 * 33], s[5 * 33]); o.w = pk2(s[6 * 33], s[7 * 33]);
        *(u32x4*)(WT + (size_t)(n0 + n) * K + k0 + 8 * c) = o; }
    __builtin_amdgcn_s_waitcnt(0); asm volatile("" ::: "memory");
}

__device__ __forceinline__ void sincos_acc(float a, float& c, float& s) {
    const double x = (double)a; const double k = rint(x * 0.63661977236758134308);
    const double r = fma(-k, 1.57079632679489661923, x), r2 = r * r;
    double sp = -2.5052108385441718775e-8; sp = sp * r2 + 2.7557319223985890653e-6; sp = sp * r2 - 1.9841269841269841270e-4; sp = sp * r2 + 8.3333333333333333333e-3; sp = sp * r2 - 1.6666666666666666667e-1; sp = r + r * r2 * sp;
    double cp = 2.0876756987868098979e-9; cp = cp * r2 - 2.7557319223985890653e-7; cp = cp * r2 + 2.4801587301587301587e-5; cp = cp * r2 - 1.3888888888888888889e-3; cp = cp * r2 + 4.1666666666666666667e-2; cp = cp * r2 - 0.5; cp = 1.0 + r2 * cp;
    const int q = ((int)k) & 3;
    const double sv = (q == 0) ? sp : (q == 1) ? cp : (q == 2) ? -sp : -cp;
    const double cv = (q == 0) ? cp : (q == 1) ? -sp : (q == 2) ? -cp : sp;
    c = (float)cv; s = (float)sv;
}

__device__ __forceinline__ void convert_weights(const Params& P, unsigned char* lds, int gw, int NGW, int wave, int lane, int it_lo, int it_hi) {
    unsigned char* ws = P.ws;
    float* scr = (float*)(lds + wave * 8704);
    constexpr int I_IN = 16 * 104, I_Q = 6 * 48, I_K = 4 * 32, I_V = 4 * 32, I_O = 32 * 32, I_U = 16 * 128, I_D = 64 * 32;
    for (int it = it_lo + gw; it < it_hi; it += NGW) {
        int r = it;
        if (r < I_IN) { const int kb = r / 104, nb = r % 104; p0_transpose_item(P.w_in, 1024, INW, (bf16_t*)(ws + WS_WIN), scr, kb * 64, nb * 32, nb * 32, INW, lane); continue; } r -= I_IN;
        if (r < I_Q) { const int kb = r / 48, nb = r % 48; p0_transpose_item(P.w_q_up, 384, 1536, (bf16_t*)(ws + WS_WQ), scr, kb * 64, nb * 32, nb * 32, 1536, lane); continue; } r -= I_Q;
        if (r < I_K) { const int kb = r / 32, nb = r % 32, n0 = nb * 32; p0_transpose_item(P.w_kv_up, 256, 2048, (bf16_t*)(ws + WS_WK), scr, kb * 64, n0, 256 * (n0 >> 7) + (n0 & 127), 1024, lane); continue; } r -= I_K;
        if (r < I_V) { const int kb = r / 32, nb = r % 32, n0 = nb * 32; p0_transpose_item(P.w_kv_up, 256, 2048, (bf16_t*)(ws + WS_WV), scr, kb * 64, n0, 256 * (n0 >> 7) + 128 + (n0 & 127), 1024, lane); continue; } r -= I_V;
        if (r < I_O) { const int kb = r / 32, nb = r % 32; p0_transpose_item(P.w_out, 2048, 1024, (bf16_t*)(ws + WS_WOUT), scr, kb * 64, nb * 32, nb * 32, 1024, lane); continue; } r -= I_O;
        if (r < I_U) { const int kb = r / 128, nb = r % 128; p0_transpose_item(P.w_up, 1024, 4096, (bf16_t*)(ws + WS_WUP), scr, kb * 64, nb * 32, nb * 32, 4096, lane); continue; } r -= I_U;
        { const int kb = r / 32, nb = r % 32; p0_transpose_item(P.w_dn, 4096, 1024, (bf16_t*)(ws + WS_WDN), scr, kb * 64, nb * 32, nb * 32, 1024, lane); }
    }
}
constexpr int W_ITEMS_IN = 16 * 104, W_ITEMS_ALL = 16 * 104 + 6 * 48 + 4 * 32 + 4 * 32 + 32 * 32 + 16 * 128 + 64 * 32;
__device__ __forceinline__ void phase0(const Params& P, unsigned char* lds, int gw, int NGW, int wave, int lane) {
    unsigned char* ws = P.ws;
    convert_weights(P, lds, gw, NGW, wave, lane, 0, W_ITEMS_IN);
    bf16_t* hn = (bf16_t*)(ws + WS_HN);
    for (int m = gw; m < MP; m += NGW) {
        unsigned long long* o8 = (unsigned long long*)(hn + (size_t)m * DM) + lane;
        if (m >= L) {
#pragma unroll
            for (int j = 0; j < 4; ++j) o8[64 * j] = 0ull;
            continue; }
        const float* xrow = (m < NMETA) ? (P.meta + (size_t)m * DM) : (P.x + (size_t)(m - NMETA) * DM);
        const f32x4* xr = (const f32x4*)xrow + lane; const f32x4* gr = (const f32x4*)P.g_mix_pre + lane;
        f32x4 v[4]; float s = 0.f;
#pragma unroll
        for (int j = 0; j < 4; ++j) { v[j] = xr[64 * j]; s += (v[j].x * v[j].x + v[j].y * v[j].y) + (v[j].z * v[j].z + v[j].w * v[j].w); }
        const float rstd = rsqrtf(wave_sum(s) * (1.f / DM) + EPS);
#pragma unroll
        for (int j = 0; j < 4; ++j) { const f32x4 g = gr[64 * j];
            o8[64 * j] = (unsigned long long)pk2(v[j].x * rstd * g.x, v[j].y * rstd * g.y) | ((unsigned long long)pk2(v[j].z * rstd * g.z, v[j].w * rstd * g.w) << 32); }
    }
}
__device__ __forceinline__ void build_rope(const Params& P, int gw, int NGW, int lane) {
    float2* rope = (float2*)(P.ws + WS_ROPE);
    for (int i = gw * 64 + lane; i < L * 32; i += NGW * 64) { const int pos = i >> 5, j = i & 31; const float a = (float)pos * P.invf[j]; float c, s; sincos_acc(a, c, s); rope[i] = make_float2(c, s); }
}

__device__ __forceinline__ void phase_latn(const Params& P, int gw, int NGW, int lane) {
    bf16_t* lat = (bf16_t*)(P.ws + WS_LAT); bf16_t* kr = (bf16_t*)(P.ws + WS_KR); const float2* rope = (const float2*)(P.ws + WS_ROPE);
    for (int m0 = 2 * gw; m0 < MP; m0 += 2 * NGW) {
        float q[2][6], kv[2][4], x1[2], x2[2];
#pragma unroll
        for (int t = 0; t < 2; ++t) { const bf16_t* row = lat + (size_t)(m0 + t) * LATW;
#pragma unroll
            for (int i = 0; i < 6; ++i) q[t][i] = bf2f(row[lane + 64 * i]);
#pragma unroll
            for (int i = 0; i < 4; ++i) kv[t][i] = bf2f(row[384 + lane + 64 * i]);
            x1[t] = 0.f; x2[t] = 0.f; if (lane < 32) { x1[t] = bf2f(row[640 + lane]); x2[t] = bf2f(row[672 + lane]); } }
#pragma unroll
        for (int t = 0; t < 2; ++t) { const int m = m0 + t; bf16_t* row = lat + (size_t)m * LATW;
            float sq = 0.f, sk = 0.f;
#pragma unroll
            for (int i = 0; i < 6; ++i) sq += q[t][i] * q[t][i];
#pragma unroll
            for (int i = 0; i < 4; ++i) sk += kv[t][i] * kv[t][i];
            const float rq = rsqrtf(wave_sum(sq) * (1.f / 384.f) + EPS), rk = rsqrtf(wave_sum(sk) * (1.f / 256.f) + EPS);
#pragma unroll
            for (int i = 0; i < 6; ++i) row[lane + 64 * i] = f2bf(q[t][i] * rq * P.g_qa[lane + 64 * i]);
#pragma unroll
            for (int i = 0; i < 4; ++i) row[384 + lane + 64 * i] = f2bf(kv[t][i] * rk * P.g_kva[lane + 64 * i]);
            if (lane < 32) {
                float o1 = 0.f, o2 = 0.f;
                if (m < L) { const float2 cs = rope[m * 32 + lane]; o1 = x1[t] * cs.x - x2[t] * cs.y; o2 = x2[t] * cs.x + x1[t] * cs.y; }
                kr[(size_t)m * 64 + lane] = f2bf(o1); kr[(size_t)m * 64 + 32 + lane] = f2bf(o2);
            } }
    }
}

__device__ __forceinline__ void conv8(const bf16_t* xbc, const float* cw, const float* cb, int t, int ch, float (&o)[8]) {
    u32x4 u[4]; f32x4 w0[4], w1[4];
#pragma unroll
    for (int k = 0; k < 4; ++k) { const int tt = t - 3 + k, tc = tt < 0 ? 0 : tt;
        u[k] = *(const u32x4*)(xbc + (size_t)tc * XBCW + ch); w0[k] = *(const f32x4*)(cw + k * XBCW + ch); w1[k] = *(const f32x4*)(cw + k * XBCW + ch + 4); }
    { const f32x4 b0 = *(const f32x4*)(cb + ch), b1 = *(const f32x4*)(cb + ch + 4); o[0] = b0.x; o[1] = b0.y; o[2] = b0.z; o[3] = b0.w; o[4] = b1.x; o[5] = b1.y; o[6] = b1.z; o[7] = b1.w; }
#pragma unroll
    for (int k = 0; k < 4; ++k) { const float mk = (t - 3 + k >= 0) ? 1.f : 0.f; const f32x4 a = w0[k] * mk, b = w1[k] * mk;
        o[0] += a.x * bf_lo(u[k].x); o[1] += a.y * bf_hi(u[k].x); o[2] += a.z * bf_lo(u[k].y); o[3] += a.w * bf_hi(u[k].y);
        o[4] += b.x * bf_lo(u[k].z); o[5] += b.y * bf_hi(u[k].z); o[6] += b.z * bf_lo(u[k].w); o[7] += b.w * bf_hi(u[k].w); }
#pragma unroll
    for (int i = 0; i < 8; ++i) o[i] = silu(o[i]);
}
struct ConvW { f32x4 w0[4], w1[4], b0, b1; };
__device__ __forceinline__ void convw_load(ConvW& W, const float* cw, const float* cb, int ch) {
#pragma unroll
    for (int k = 0; k < 4; ++k) { W.w0[k] = *(const f32x4*)(cw + k * XBCW + ch); W.w1[k] = *(const f32x4*)(cw + k * XBCW + ch + 4); }
    W.b0 = *(const f32x4*)(cb + ch); W.b1 = *(const f32x4*)(cb + ch + 4);
}
template <int NR> __device__ __forceinline__ void conv_rows_load(const bf16_t* xbc, int t0, int ch, u32x4 (&u)[NR + 3]) {
#pragma unroll
    for (int i = 0; i < NR + 3; ++i) { const int tt = t0 - 3 + i, tc = tt < 0 ? 0 : tt; const u32x4 v = *(const u32x4*)(xbc + (size_t)tc * XBCW + ch); u[i] = (tt >= 0) ? v : (u32x4){0u, 0u, 0u, 0u}; }
}
template <int NR> __device__ __forceinline__ void conv_row_out(const ConvW& W, const u32x4 (&u)[NR + 3], int r, float (&o)[8]) {
    o[0] = W.b0.x; o[1] = W.b0.y; o[2] = W.b0.z; o[3] = W.b0.w; o[4] = W.b1.x; o[5] = W.b1.y; o[6] = W.b1.z; o[7] = W.b1.w;
#pragma unroll
    for (int k = 0; k < 4; ++k) { const u32x4 v = u[r + k]; const f32x4 a = W.w0[k], b = W.w1[k];
        o[0] += a.x * bf_lo(v.x); o[1] += a.y * bf_hi(v.x); o[2] += a.z * bf_lo(v.y); o[3] += a.w * bf_hi(v.y);
        o[4] += b.x * bf_lo(v.z); o[5] += b.y * bf_hi(v.z); o[6] += b.z * bf_lo(v.w); o[7] += b.w * bf_hi(v.w); }
#pragma unroll
    for (int i = 0; i < 8; ++i) o[i] = silu(o[i]);
}
__device__ __forceinline__ int pi32(int m) { const int a = m >> 3, h = (m >> 2) & 1, b = m & 3; return 16 * (a >> 1) + 8 * h + 4 * (a & 1) + b; }
__device__ __forceinline__ int crow(int r, int hi) { return (r & 3) + 8 * (r >> 2) + 4 * hi; }

constexpr int SP = 272;
__device__ __forceinline__ float chunk_scan(const float* dtg, int r0, int valid, int h, float ah, float* acum, float* dtv, int lane) {
    const int s0 = 2 * lane, s1 = 2 * lane + 1;
    const float d0 = (s0 < valid) ? dtg[(size_t)(r0 + s0) * 16 + h] : 0.f, d1 = (s1 < valid) ? dtg[(size_t)(r0 + s1) * 16 + h] : 0.f;
    const float a0 = d0 * ah, a1 = d1 * ah, c = a0 + a1; float incl = c;
#pragma unroll
    for (int o = 1; o < 64; o <<= 1) { const float t = __shfl_up(incl, o); if (lane >= o) incl += t; }
    const float excl = incl - c;
    acum[s0] = excl + a0; acum[s1] = incl; dtv[s0] = d0; dtv[s1] = d1;
    return __shfl(incl, 63);
}

__device__ __forceinline__ void phase_ssd_states(const Params& P, unsigned char* lds, int tid, int wave, int lane) {
    const bf16_t* xbc = (const bf16_t*)(P.ws + WS_XBC); const float* dtg = (const float*)(P.ws + WS_DT);
    bf16_t* st = (bf16_t*)(P.ws + WS_ST); float* cdec = (float*)(P.ws + WS_CDEC); bf16_t* bconv = (bf16_t*)(P.ws + WS_BCONV); bf16_t* mixx = (bf16_t*)(P.ws + WS_MIX);
    unsigned char* Bt = lds;
    unsigned char* XT = lds + 128 * SP + wave * (32 * SP);
    float* acum = (float*)(lds + 128 * SP + 8 * 32 * SP) + wave * 256; float* wts = acum + 128;
    const int r32 = lane & 31, hi = lane >> 5;
    for (int item = blockIdx.x; item < NCH * 2; item += gridDim.x) {
        const int c = item >> 1, g = item & 1; const int r0 = (c == 0) ? 0 : NMETA + 128 * (c - 1), valid = (c == 0) ? NMETA : 128;
        __syncthreads();
        {
            const int n8 = (tid & 15) * 8, s0 = (tid >> 4) * 4, chB = 1024 + g * 128 + n8;
            if (s0 < valid) {
                ConvW W; convw_load(W, P.conv_w, P.conv_b, chB); u32x4 u[7]; conv_rows_load<4>(xbc, r0 + s0, chB, u);
#pragma unroll
                for (int rp = 0; rp < 2; ++rp) { float oa[8], ob[8]; conv_row_out<4>(W, u, 2 * rp, oa); conv_row_out<4>(W, u, 2 * rp + 1, ob);
                    const int sa = s0 + 2 * rp;
                    { u32x4 w; w.x = pk2(oa[0], oa[1]); w.y = pk2(oa[2], oa[3]); w.z = pk2(oa[4], oa[5]); w.w = pk2(oa[6], oa[7]); *(u32x4*)(bconv + (size_t)(r0 + sa) * 256 + g * 128 + n8) = w; }
                    { u32x4 w; w.x = pk2(ob[0], ob[1]); w.y = pk2(ob[2], ob[3]); w.z = pk2(ob[4], ob[5]); w.w = pk2(ob[6], ob[7]); *(u32x4*)(bconv + (size_t)(r0 + sa + 1) * 256 + g * 128 + n8) = w; }
#pragma unroll
                    for (int i = 0; i < 8; ++i) *(unsigned*)(Bt + (n8 + i) * SP + sa * 2) = pk2(oa[i], ob[i]); }
            } else {
#pragma unroll
                for (int rp = 0; rp < 2; ++rp)
#pragma unroll
                    for (int i = 0; i < 8; ++i) *(unsigned*)(Bt + (n8 + i) * SP + (s0 + 2 * rp) * 2) = 0u; }
        }
        const int h = g * 8 + wave; const float ah = -__expf(P.a_log[h]);
        const float total = chunk_scan(dtg, r0, valid, h, ah, acum, wts + 0, lane);
        { const int s0 = 2 * lane; const float w0 = __expf(total - acum[s0]) * wts[s0], w1 = __expf(total - acum[s0 + 1]) * wts[s0 + 1]; wts[s0] = w0; wts[s0 + 1] = w1; }
        if (lane == 0) cdec[c * 16 + h] = __expf(total);
        __syncthreads();
        for (int ph = 0; ph < 2; ++ph) {
            {
                const int p8 = (lane & 3) * 8, s0 = (lane >> 2) * 8, chX = h * 64 + ph * 32 + p8;
                if (s0 < valid) {
                    ConvW W; convw_load(W, P.conv_w, P.conv_b, chX); u32x4 u[11]; conv_rows_load<8>(xbc, r0 + s0, chX, u);
#pragma unroll
                    for (int rp = 0; rp < 4; ++rp) { float oa[8], ob[8]; conv_row_out<8>(W, u, 2 * rp, oa); conv_row_out<8>(W, u, 2 * rp + 1, ob);
                        const int sa = s0 + 2 * rp; const float wa = wts[sa], wb2 = wts[sa + 1];
                        { u32x4 wv; wv.x = pk2(oa[0], oa[1]); wv.y = pk2(oa[2], oa[3]); wv.z = pk2(oa[4], oa[5]); wv.w = pk2(oa[6], oa[7]); *(u32x4*)(mixx + (size_t)(r0 + sa) * 2048 + 1024 + chX) = wv; }
                        { u32x4 wv; wv.x = pk2(ob[0], ob[1]); wv.y = pk2(ob[2], ob[3]); wv.z = pk2(ob[4], ob[5]); wv.w = pk2(ob[6], ob[7]); *(u32x4*)(mixx + (size_t)(r0 + sa + 1) * 2048 + 1024 + chX) = wv; }
#pragma unroll
                        for (int i = 0; i < 8; ++i) *(unsigned*)(XT + (p8 + i) * SP + sa * 2) = pk2(oa[i] * wa, ob[i] * wb2); }
                } else {
#pragma unroll
                    for (int rp = 0; rp < 4; ++rp)
#pragma unroll
                        for (int i = 0; i < 8; ++i) *(unsigned*)(XT + (p8 + i) * SP + (s0 + 2 * rp) * 2) = 0u; }
            }
            __builtin_amdgcn_s_waitcnt(0); asm volatile("" ::: "memory");
            f32x16 acc[4];
#pragma unroll
            for (int nb = 0; nb < 4; ++nb) acc[nb] = f32x16{};
            const int nks = (valid + 15) >> 4;
            for (int ks = 0; ks < nks; ++ks) { const bf16x8 xf = *(const bf16x8*)(XT + r32 * SP + (16 * ks + 8 * hi) * 2);
#pragma unroll
                for (int nb = 0; nb < 4; ++nb) { const bf16x8 bfr = *(const bf16x8*)(Bt + (32 * nb + r32) * SP + (16 * ks + 8 * hi) * 2);
                    acc[nb] = __builtin_amdgcn_mfma_f32_32x32x16_bf16(bfr, xf, acc[nb], 0, 0, 0); } }
#pragma unroll
            for (int nb = 0; nb < 4; ++nb)
#pragma unroll
                for (int rg = 0; rg < 4; ++rg) { u32x2 w; w.x = pk2(acc[nb][4 * rg], acc[nb][4 * rg + 1]); w.y = pk2(acc[nb][4 * rg + 2], acc[nb][4 * rg + 3]);
                    *(u32x2*)(XT + r32 * SP + (32 * nb + 8 * rg + 4 * hi) * 2) = w; }
            __builtin_amdgcn_s_waitcnt(0); asm volatile("" ::: "memory");
            bf16_t* so = st + ((size_t)c * 16 + h) * 8192 + (size_t)(ph * 32) * 128;
#pragma unroll
            for (int it = 0; it < 8; ++it) { const int p = it * 4 + (lane >> 4), ch = lane & 15;
                *(u32x4*)(so + p * 128 + ch * 8) = *(const u32x4*)(XT + p * SP + ch * 16); }
            __builtin_amdgcn_s_waitcnt(0); asm volatile("" ::: "memory");
        }
    }
    __syncthreads();
}

__device__ __forceinline__ void phase_scan(const Params& P, int tid) {
    unsigned* st = (unsigned*)(P.ws + WS_ST); const float* cdec = (const float*)(P.ws + WS_CDEC);
    if (tid < 256) {
        for (int e0 = blockIdx.x * 512; e0 < 131072; e0 += gridDim.x * 512) {
            const int h = __builtin_amdgcn_readfirstlane(e0 >> 13);
            unsigned* pe = st + ((e0 >> 1) + tid);
            float h0 = 0.f, h1 = 0.f;
#pragma nounroll
            for (int seg = 0; seg < 3; ++seg) {
                unsigned v[43]; unsigned* ps = pe + (size_t)(43 * seg) * 65536; const float* dcp = cdec + (43 * seg) * 16 + h;
#pragma unroll
                for (int c = 0; c < 43; ++c) v[c] = ps[(size_t)c * 65536];
#pragma unroll
                for (int c = 0; c < 43; ++c) { const float dc = dcp[c * 16]; ps[(size_t)c * 65536] = pk2(h0, h1); h0 = dc * h0 + bf_lo(v[c]); h1 = dc * h1 + bf_hi(v[c]); }
            }
        }
    }
}

__device__ __forceinline__ void phase_ssd_y(const Params& P, unsigned char* lds, int tid, int wave, int lane) {
    const bf16_t* xbc = (const bf16_t*)(P.ws + WS_XBC); const float* dtg = (const float*)(P.ws + WS_DT); const bf16_t* zb = (const bf16_t*)(P.ws + WS_Z);
    const bf16_t* st = (const bf16_t*)(P.ws + WS_ST); bf16_t* mix = (bf16_t*)(P.ws + WS_MIX); const bf16_t* bconv = (const bf16_t*)(P.ws + WS_BCONV);
    unsigned char* Bs = lds; unsigned char* Cs = lds + 128 * SP;
    unsigned char* XT = lds + 2 * 128 * SP + wave * (32 * SP);
    unsigned char* YS = XT;
    float* acum = (float*)(lds + 2 * 128 * SP + 8 * 32 * SP) + wave * 384; float* dtv = acum + 128; float* gtab = acum + 256;
    float* rowss = (float*)(lds + 2 * 128 * SP + 8 * 32 * SP + 8 * 1536);
    static_assert(2 * 128 * SP + 8 * 32 * SP + 8 * 1536 + 8192 <= LDS_BYTES - 64, "ssd_y LDS");
    const int r32 = lane & 31, hi = lane >> 5;
    for (int item = blockIdx.x; item < NCH * 2; item += gridDim.x) {
        const int c = item >> 1, g = item & 1; const int r0 = (c == 0) ? 0 : NMETA + 128 * (c - 1), valid = (c == 0) ? NMETA : 128;
        __syncthreads();
        for (int ck = tid; ck < 4096; ck += 512) { const int isC = ck >> 11, c2 = ck & 2047, s = c2 >> 4, n8 = (c2 & 15) * 8; float o[8];
            u32x4 w = {0u, 0u, 0u, 0u};
            if (s < valid) { if (isC) { conv8(xbc, P.conv_w, P.conv_b, r0 + s, 1280 + g * 128 + n8, o); w.x = pk2(o[0], o[1]); w.y = pk2(o[2], o[3]); w.z = pk2(o[4], o[5]); w.w = pk2(o[6], o[7]); }
                             else w = *(const u32x4*)(bconv + (size_t)(r0 + s) * 256 + g * 128 + n8); }
            *(u32x4*)((isC ? Cs : Bs) + s * SP + n8 * 2) = w; }
        const int h = g * 8 + wave; const float ah = -__expf(P.a_log[h]); const float dsk = P.d_skip[h];
        (void)chunk_scan(dtg, r0, valid, h, ah, acum, dtv, lane);
        { const int s0 = 2 * lane; const float R = acum[(s0 & ~31) + 31]; gtab[s0] = __expf(R - acum[s0]) * dtv[s0]; gtab[s0 + 1] = __expf(R - acum[s0 + 1]) * dtv[s0 + 1]; }
        __syncthreads();
        for (int ph = 0; ph < 2; ++ph) {
            for (int ck = lane; ck < 512; ck += 64) { const int s = ck >> 2, p8 = (ck & 3) * 8; float o[8];
                u32x4 xv = {0u, 0u, 0u, 0u};
                if (s < valid) xv = *(const u32x4*)(mix + (size_t)(r0 + s) * 2048 + 1024 + h * 64 + ph * 32 + p8);
                (void)o;
#pragma unroll
                for (int i = 0; i < 4; ++i) { *(bf16_t*)(XT + (p8 + 2 * i) * SP + s * 2) = (bf16_t)(xv[i] & 0xffffu); *(bf16_t*)(XT + (p8 + 2 * i + 1) * SP + s * 2) = (bf16_t)(xv[i] >> 16); } }
            bf16x8 pvf[8];
            { const bf16_t* pv = st + ((size_t)c * 16 + h) * 8192 + (size_t)(ph * 32 + r32) * 128 + 8 * hi;
#pragma unroll
              for (int ks = 0; ks < 8; ++ks) pvf[ks] = *(const bf16x8*)(pv + 16 * ks); }
            __builtin_amdgcn_s_waitcnt(0); asm volatile("" ::: "memory");
            const int nlb = (valid + 31) >> 5;
            u32x2 yp[4][4];
#pragma unroll
            for (int q4 = 0; q4 < 4; ++q4)
#pragma unroll
                for (int rg = 0; rg < 4; ++rg) yp[q4][rg] = (u32x2){0u, 0u};
            for (int lb = 0; lb < nlb; ++lb) {
                const int l = 32 * lb + r32;
                bf16x8 cf[8];
#pragma unroll
                for (int ks = 0; ks < 8; ++ks) cf[ks] = *(const bf16x8*)(Cs + l * SP + (16 * ks + 8 * hi) * 2);
                f32x16 accd = f32x16{}, acco = f32x16{};
#pragma unroll
                for (int ks = 0; ks < 8; ++ks) acco = __builtin_amdgcn_mfma_f32_32x32x16_bf16(pvf[ks], cf[ks], acco, 0, 0, 0);
                const float al = acum[l];
                for (int sb = 0; sb <= lb; ++sb) {
                    f32x16 sT = f32x16{};
                    const unsigned char* brow = Bs + (32 * sb + pi32(r32)) * SP + 16 * hi;
                    { bf16x8 bb[2]; bb[0] = *(const bf16x8*)(brow); bb[1] = *(const bf16x8*)(brow + 32);
#pragma unroll
                      for (int ks = 0; ks < 8; ++ks) { sT = __builtin_amdgcn_mfma_f32_32x32x16_bf16(bb[ks & 1], cf[ks], sT, 0, 0, 0); if (ks + 2 < 8) bb[ks & 1] = *(const bf16x8*)(brow + 32 * (ks + 2)); } }
                    unsigned wb[8];
                    if (sb < lb) {
                        const float fl = __expf(al - acum[32 * sb + 31]);
#pragma unroll
                        for (int hf = 0; hf < 2; ++hf) {
                            const int sb0 = 32 * sb + 16 * hf + 8 * hi;
                            const f32x4 d0 = *(const f32x4*)(gtab + sb0), d1 = *(const f32x4*)(gtab + sb0 + 4);
#pragma unroll
                            for (int j = 0; j < 4; ++j) { const float ga = (j < 2) ? d0[2 * j] : d1[2 * j - 4], gb = (j < 2) ? d0[2 * j + 1] : d1[2 * j - 3];
                                wb[4 * hf + j] = pk2(sT[8 * hf + 2 * j] * (fl * ga), sT[8 * hf + 2 * j + 1] * (fl * gb)); } }
                    } else {
#pragma unroll
                        for (int hf = 0; hf < 2; ++hf) {
                            const int sb0 = 32 * sb + 16 * hf + 8 * hi;
                            const f32x4 a0 = *(const f32x4*)(acum + sb0), a1 = *(const f32x4*)(acum + sb0 + 4), d0 = *(const f32x4*)(dtv + sb0), d1 = *(const f32x4*)(dtv + sb0 + 4);
                            float wv[8];
#pragma unroll
                            for (int j = 0; j < 8; ++j) { const float aj = (j < 4) ? a0[j & 3] : a1[j & 3], dj = (j < 4) ? d0[j & 3] : d1[j & 3]; const int sj = sb0 + j;
                                const float e = __expf(fminf(al - aj, 0.f)) * dj; float v = sT[8 * hf + j] * e; v = (sj <= l) ? v : 0.f; v += (sj == l) ? dsk : 0.f; wv[j] = v; }
#pragma unroll
                            for (int j = 0; j < 4; ++j) wb[4 * hf + j] = pk2(wv[2 * j], wv[2 * j + 1]); } }
                    const u32x4 w0 = {wb[0], wb[1], wb[2], wb[3]}, w1 = {wb[4], wb[5], wb[6], wb[7]};
                    const bf16x8 x0 = *(const bf16x8*)(XT + r32 * SP + (32 * sb + 8 * hi) * 2), x1 = *(const bf16x8*)(XT + r32 * SP + (32 * sb + 16 + 8 * hi) * 2);
                    accd = __builtin_amdgcn_mfma_f32_32x32x16_bf16(x0, __builtin_bit_cast(bf16x8, w0), accd, 0, 0, 0);
                    accd = __builtin_amdgcn_mfma_f32_32x32x16_bf16(x1, __builtin_bit_cast(bf16x8, w1), accd, 0, 0, 0);
                }
                { const float el = __expf(al);
#pragma unroll
                  for (int rg = 0; rg < 4; ++rg) { u32x2 w; w.x = pk2(accd[4 * rg] + el * acco[4 * rg], accd[4 * rg + 1] + el * acco[4 * rg + 1]); w.y = pk2(accd[4 * rg + 2] + el * acco[4 * rg + 2], accd[4 * rg + 3] + el * acco[4 * rg + 3]);
#pragma unroll
                      for (int q4 = 0; q4 < 4; ++q4) if (q4 == lb) yp[q4][rg] = w; } }
            }
#pragma unroll
            for (int q4 = 0; q4 < 4; ++q4) if (q4 < nlb) {
#pragma unroll
                for (int rg = 0; rg < 4; ++rg) *(u32x2*)(YS + (32 * q4 + r32) * 64 + (8 * rg + 4 * hi) * 2) = yp[q4][rg]; }
            __builtin_amdgcn_s_waitcnt(0); asm volatile("" ::: "memory");
            for (int it = 0; it < 2 * nlb; ++it) { const int l = it * 16 + (lane >> 2), c8 = (lane & 3) * 8; const size_t row = (size_t)(r0 + l);
                const u32x4 yb = *(const u32x4*)(YS + l * 64 + c8 * 2); u32x4 zz = {0u, 0u, 0u, 0u};
                if (l < valid) zz = *(const u32x4*)(zb + row * 1024 + h * 64 + ph * 32 + c8);
                float gq[8]; float ss = 0.f;
#pragma unroll
                for (int j = 0; j < 4; ++j) { gq[2 * j] = bf_lo(yb[j]) * silu(bf_lo(zz[j])); gq[2 * j + 1] = bf_hi(yb[j]) * silu(bf_hi(zz[j])); ss += gq[2 * j] * gq[2 * j] + gq[2 * j + 1] * gq[2 * j + 1]; }
                ss += __shfl_xor(ss, 1); ss += __shfl_xor(ss, 2);
                if ((lane & 3) == 0) rowss[(wave * 2 + ph) * 128 + l] = ss;
                if (l < valid) { u32x4 w; w.x = pk2(gq[0], gq[1]); w.y = pk2(gq[2], gq[3]); w.z = pk2(gq[4], gq[5]); w.w = pk2(gq[6], gq[7]); *(u32x4*)(mix + row * 2048 + 1024 + h * 64 + ph * 32 + c8) = w; } }
            __builtin_amdgcn_s_waitcnt(0); asm volatile("" ::: "memory");
        }
        __syncthreads();
        { const int l = tid >> 2, qd = tid & 3;
          if (l < valid) { float ss = 0.f;
#pragma unroll
              for (int k = 0; k < 16; ++k) ss += rowss[k * 128 + l];
              const float rstd = rsqrtf(ss * (1.f / 512.f) + EPS);
              bf16_t* rp = mix + (size_t)(r0 + l) * 2048 + 1024 + g * 512 + qd * 128; const float* gp = P.g_ssm + g * 512 + qd * 128;
#pragma unroll 4
              for (int k = 0; k < 16; ++k) { const u32x4 u = *(const u32x4*)(rp + 8 * k); const f32x4 g0 = *(const f32x4*)(gp + 8 * k), g1 = *(const f32x4*)(gp + 8 * k + 4);
                  u32x4 w; w.x = pk2(bf_lo(u.x) * rstd * g0.x, bf_hi(u.x) * rstd * g0.y); w.y = pk2(bf_lo(u.y) * rstd * g0.z, bf_hi(u.y) * rstd * g0.w);
                  w.z = pk2(bf_lo(u.z) * rstd * g1.x, bf_hi(u.z) * rstd * g1.y); w.w = pk2(bf_lo(u.w) * rstd * g1.z, bf_hi(u.w) * rstd * g1.w);
                  *(u32x4*)(rp + 8 * k) = w; } } }
    }
    __syncthreads();
}

namespace att {
constexpr int KP = 400, VP = 144, KT_BYTES = 64 * KP, VT_BYTES = 128 * VP, STG = KT_BYTES + VT_BYTES;
struct Stage { u32x4 k0, k1, kr, v0, v1; };
__device__ __forceinline__ void gload(Stage& s, const bf16_t* kb, const bf16_t* krb, const bf16_t* vt, int h, int kbase, int tid) {
    s.k0 = *(const u32x4*)(kb + (size_t)(kbase + (tid >> 4)) * 1024 + h * 128 + (tid & 15) * 8);
    s.k1 = *(const u32x4*)(kb + (size_t)(kbase + 32 + (tid >> 4)) * 1024 + h * 128 + (tid & 15) * 8);
    s.kr = *(const u32x4*)(krb + (size_t)(kbase + (tid >> 3)) * 64 + (tid & 7) * 8);
    s.v0 = *(const u32x4*)(vt + (size_t)(h * 128 + (tid >> 3)) * MP + kbase + (tid & 7) * 8);
    s.v1 = *(const u32x4*)(vt + (size_t)(h * 128 + 64 + (tid >> 3)) * MP + kbase + (tid & 7) * 8);
}
__device__ __forceinline__ void sstore(const Stage& s, unsigned char* buf, int tid) {
    unsigned char* Kt = buf; unsigned char* Vt = buf + KT_BYTES;
    *(u32x4*)(Kt + (tid >> 4) * KP + (tid & 15) * 16) = s.k0;
    *(u32x4*)(Kt + (32 + (tid >> 4)) * KP + (tid & 15) * 16) = s.k1;
    *(u32x4*)(Kt + (tid >> 3) * KP + 256 + (tid & 7) * 16) = s.kr;
    *(u32x4*)(Vt + (tid >> 3) * VP + (tid & 7) * 16) = s.v0;
    *(u32x4*)(Vt + (64 + (tid >> 3)) * VP + (tid & 7) * 16) = s.v1;
}
constexpr int VSLOT0 = 2 * KT_BYTES;
__device__ __forceinline__ void glds16(const void* gsrc, unsigned lds_dst) { unsigned keep;
    asm volatile("s_mov_b32 %0, m0\n\ts_mov_b32 m0, %2\n\ts_nop 0\n\tglobal_load_lds_dwordx4 %1, off\n\ts_mov_b32 m0, %0" : "=&s"(keep) : "v"(gsrc), "s"(lds_dst) : "memory"); }
constexpr float THR = 8.f;
__device__ __forceinline__ float max3f(float a, float b, float c) { float r; asm("v_max3_f32 %0, %1, %2, %3" : "=v"(r) : "v"(a), "v"(b), "v"(c)); return r; }
__device__ __forceinline__ float max2f(float a, float b) { float r; asm("v_max_f32_e32 %0, %1, %2" : "=v"(r) : "v"(a), "v"(b)); return r; }
__device__ __forceinline__ float xhalf_max(float m) { auto rr = __builtin_amdgcn_permlane32_swap(__float_as_uint(m), __float_as_uint(m), false, false); return max2f(__uint_as_float(rr[0]), __uint_as_float(rr[1])); }
#define ATT_SB() __builtin_amdgcn_sched_barrier(0)
__device__ __forceinline__ void unit(const Params& P, unsigned char* lds, int h, int q0, int NT, int slo, int shi, int tid, int wave, int lane) {
    const bf16_t* qb = (const bf16_t*)(P.ws + WS_Q); const bf16_t* kb = (const bf16_t*)(P.ws + WS_K); const bf16_t* krb = (const bf16_t*)(P.ws + WS_KR);
    const bf16_t* vt = (const bf16_t*)(P.ws + WS_VT); bf16_t* mix = (bf16_t*)(P.ws + WS_MIX); const float2* rope = (const float2*)(P.ws + WS_ROPE);
    const int r32 = lane & 31, hi = lane >> 5;
    const int qrow = q0 + 32 * wave + r32;
    const unsigned lds0 = (unsigned)(uintptr_t)lds;
    unsigned koff[4], voff[3];
#pragma unroll
    for (int j = 0; j < 4; ++j) { const int i = 64 * (wave + 8 * j) + lane, row = i / 25, col = i - 25 * row;
        if (col >= 16 && col < 24) koff[j] = ((unsigned)WS_KR + (unsigned)((row * 64 + (col - 16) * 8) * 2)) | 1u;
        else koff[j] = (unsigned)WS_K + (unsigned)((row * 1024 + h * 128 + (col < 16 ? col : 0) * 8) * 2); }
#pragma unroll
    for (int j = 0; j < 3; ++j) { const int i = 64 * (wave + 8 * j) + lane, d = i / 9, c = i - 9 * d; voff[j] = (unsigned)WS_VT + (unsigned)(((h * 128 + d) * MP + (c < 8 ? c : 0) * 8) * 2); }
#define ATT_ISSUE(t, kslot, vslot) do { const unsigned t_ = (unsigned)(t); \
        _Pragma("unroll") for (int j = 0; j < 4; ++j) if (wave + 8 * j < 25) glds16(P.ws + ((koff[j] & ~1u) + t_ * ((koff[j] & 1u) ? 64u * 128u : 64u * 2048u)), (unsigned)__builtin_amdgcn_readfirstlane(lds0 + (kslot) * KT_BYTES + (wave + 8 * j) * 1024)); \
        _Pragma("unroll") for (int j = 0; j < 3; ++j) if (wave + 8 * j < 18) glds16(P.ws + (voff[j] + t_ * 128u), (unsigned)__builtin_amdgcn_readfirstlane(lds0 + VSLOT0 + (vslot) * VT_BYTES + (wave + 8 * j) * 1024)); } while (0)
#define ATT_ISSUE1(slot, t, kslot, vslot) do { const unsigned t_ = (unsigned)(t); \
        if ((slot) < 4) { if (wave + 8 * (slot) < 25) glds16(P.ws + ((koff[(slot) & 3] & ~1u) + t_ * ((koff[(slot) & 3] & 1u) ? 64u * 128u : 64u * 2048u)), (unsigned)__builtin_amdgcn_readfirstlane(lds0 + (kslot) * KT_BYTES + (wave + 8 * (slot)) * 1024)); } \
        else { if (wave + 8 * ((slot) - 4) < 18) glds16(P.ws + (voff[((slot) - 4) % 3] + t_ * 128u), (unsigned)__builtin_amdgcn_readfirstlane(lds0 + VSLOT0 + (vslot) * VT_BYTES + (wave + 8 * ((slot) - 4)) * 1024)); } } while (0)
    ATT_ISSUE(0, 0, 0);
    bf16x8 qf[12];
    { const bf16_t* qp = qb + (size_t)qrow * QW + h * 192 + 8 * hi;
#pragma unroll
      for (int ks = 0; ks < 12; ++ks) qf[ks] = *(const bf16x8*)(qp + 16 * ks);
#pragma unroll
      for (int kk = 0; kk < 2; ++kk) { u32x4 a = __builtin_bit_cast(u32x4, qf[8 + kk]), b = __builtin_bit_cast(u32x4, qf[10 + kk]); u32x4 oa, ob;
          const float2* cs = rope + (size_t)qrow * 32 + 16 * kk + 8 * hi;
#pragma unroll
          for (int j = 0; j < 4; ++j) { const float2 c0 = cs[2 * j], c1 = cs[2 * j + 1];
              const float x1a = bf_lo(a[j]), x1b = bf_hi(a[j]), x2a = bf_lo(b[j]), x2b = bf_hi(b[j]);
              oa[j] = pk2(x1a * c0.x - x2a * c0.y, x1b * c1.x - x2b * c1.y); ob[j] = pk2(x2a * c0.x + x1a * c0.y, x2b * c1.x + x1b * c1.y); }
          qf[8 + kk] = __builtin_bit_cast(bf16x8, oa); qf[10 + kk] = __builtin_bit_cast(bf16x8, ob); } }
    f32x16 o[4];
#pragma unroll
    for (int d = 0; d < 4; ++d) o[d] = f32x16{};
    float mref = 0.f, lsum = 0.f;
    asm volatile("s_waitcnt vmcnt(0)" ::: "memory");
    __syncthreads();
    const int qmin_w = q0 + 32 * wave, qmax_w = qmin_w + 31;
    const int krow_off = pi32(r32) * KP + 16 * hi;
    f32x16 sA = f32x16{}, sB = f32x16{};
    u32x4 onesf = {hi == 0 ? 0x00003F80u : 0u, 0u, 0u, 0u}, mshf = {0u, 0u, 0u, 0u};
    auto bfround = [](float v) { return __uint_as_float(pk2(v, 0.f) << 16); };
    u32x4 pw0 = {0u, 0u, 0u, 0u}, pw1 = {0u, 0u, 0u, 0u};
#define ATT_FIN4(PC, B) do { lsum += (PC[B] + PC[B + 1]) + (PC[B + 2] + PC[B + 3]); } while (0)
#define ATT_PV(HP) do { const unsigned char* Vh = lds + VSLOT0 + ((((HP) >> 1) % 3) * VT_BYTES) + r32 * VP + (32 * ((HP) & 1) + 8 * hi) * 2; \
        _Pragma("unroll") for (int d = 0; d < 4; ++d) { const bf16x8 v0 = *(const bf16x8*)(Vh + 32 * d * VP), v1 = *(const bf16x8*)(Vh + 32 * d * VP + 32); \
            o[d] = __builtin_amdgcn_mfma_f32_32x32x16_bf16(v0, __builtin_bit_cast(bf16x8, pw0), o[d], 0, 0, 0); o[d] = __builtin_amdgcn_mfma_f32_32x32x16_bf16(v1, __builtin_bit_cast(bf16x8, pw1), o[d], 0, 0, 0); } } while (0)
#define ATT_QKCHAIN(SN, kp_, DMAON, tn_, ksl_, vsl_) do { \
        { const f32x16 z16_ = {0.f, 0.f, 0.f, 0.f, 0.f, 0.f, 0.f, 0.f, 0.f, 0.f, 0.f, 0.f, 0.f, 0.f, 0.f, 0.f}; SN = z16_; } \
        bf16x8 ka_[2]; ka_[0] = *(const bf16x8*)(kp_); ka_[1] = *(const bf16x8*)(kp_ + 32); \
        _Pragma("unroll") for (int ks = 0; ks < 12; ++ks) { \
            SN = __builtin_amdgcn_mfma_f32_32x32x16_bf16(ka_[ks & 1], qf[ks], SN, 0, 0, 0); \
            if (ks + 2 < 12) ka_[ks & 1] = *(const bf16x8*)(kp_ + 32 * (ks + 2)); \
            if ((DMAON) == 1) { if (ks == 2) ATT_ISSUE1(0, tn_, ksl_, vsl_); else if (ks == 5) ATT_ISSUE1(1, tn_, ksl_, vsl_); else if (ks == 8) ATT_ISSUE1(2, tn_, ksl_, vsl_); else if (ks == 11) ATT_ISSUE1(3, tn_, ksl_, vsl_); } \
            else if ((DMAON) == 2) { if (ks == 2) ATT_ISSUE1(4, tn_, ksl_, vsl_); else if (ks == 5) ATT_ISSUE1(5, tn_, ksl_, vsl_); else if (ks == 8) ATT_ISSUE1(6, tn_, ksl_, vsl_); } } } while (0)
#define ATT_ROWSUM(PC) do { float la_ = 0.f; \
        asm("v_add_f32_e32 %0, %0, %2\n\tv_add_f32_e32 %1, %1, %3\n\tv_add_f32_e32 %0, %0, %4\n\tv_add_f32_e32 %1, %1, %5\n\t" \
            "v_add_f32_e32 %0, %0, %6\n\tv_add_f32_e32 %1, %1, %7\n\tv_add_f32_e32 %0, %0, %8\n\tv_add_f32_e32 %1, %1, %9\n\t" \
            "v_add_f32_e32 %0, %0, %10\n\tv_add_f32_e32 %1, %1, %11\n\tv_add_f32_e32 %0, %0, %12\n\tv_add_f32_e32 %1, %1, %13\n\t" \
            "v_add_f32_e32 %0, %0, %14\n\tv_add_f32_e32 %1, %1, %15\n\tv_add_f32_e32 %0, %0, %16\n\tv_add_f32_e32 %1, %1, %17\n\t" \
            "v_add_f32_e32 %0, %0, %1" \
            : "+v"(lsum), "+v"(la_) : "v"(PC[0]), "v"(PC[1]), "v"(PC[2]), "v"(PC[3]), "v"(PC[4]), "v"(PC[5]), "v"(PC[6]), "v"(PC[7]), \
              "v"(PC[8]), "v"(PC[9]), "v"(PC[10]), "v"(PC[11]), "v"(PC[12]), "v"(PC[13]), "v"(PC[14]), "v"(PC[15])); } while (0)
#define ATT_EXPPACK(PC) do { \
        _Pragma("unroll") for (int r = 0; r < 16; ++r) PC[r] = __builtin_amdgcn_exp2f(PC[r]); \
        ATT_SB();     \
        ATT_ROWSUM(PC); \
        pw0.x = pk2(PC[0], PC[1]); pw0.y = pk2(PC[2], PC[3]); pw0.z = pk2(PC[4], PC[5]); pw0.w = pk2(PC[6], PC[7]); \
        pw1.x = pk2(PC[8], PC[9]); pw1.y = pk2(PC[10], PC[11]); pw1.z = pk2(PC[12], PC[13]); pw1.w = pk2(PC[14], PC[15]); } while (0)
#define ATT_STEP(SN, PC, hh, KtP, FIRST, DMAON, tn_, ksl_, vsl_) do { \
        { \
            const unsigned char* kp_ = (KtP) + 32 * ((hh) & 1) * KP + krow_off; \
              \
            ATT_QKCHAIN(SN, kp_, DMAON, tn_, ksl_, vsl_); \
            if (!(FIRST)) { ATT_EXPPACK(PC); } \
            if (!(FIRST)) SN = __builtin_amdgcn_mfma_f32_32x32x16_bf16(__builtin_bit_cast(bf16x8, onesf), __builtin_bit_cast(bf16x8, mshf), SN, 0, 0, 0);     \
              \
            if (32 * (hh) + 31 > qmin_w) { const int kq_ = qrow - 32 * (hh) - 8 * hi; \
                _Pragma("unroll") for (int r = 0; r < 16; ++r) SN[r] = ((16 * (r >> 3) + (r & 7)) > kq_) ? -1e30f : SN[r]; } \
            float mx_; \
            if (!(FIRST)) { \
                const unsigned char* Vh = lds + VSLOT0 + (((((hh) - 1) >> 1) % 3) * VT_BYTES) + r32 * VP + (32 * (((hh) - 1) & 1) + 8 * hi) * 2; \
                bf16x8 va_[2]; va_[0] = *(const bf16x8*)(Vh); va_[1] = *(const bf16x8*)(Vh + 32); \
                _Pragma("unroll") for (int i = 0; i < 8; ++i) { \
                    o[i >> 1] = __builtin_amdgcn_mfma_f32_32x32x16_bf16(va_[i & 1], __builtin_bit_cast(bf16x8, (i & 1) ? pw1 : pw0), o[i >> 1], 0, 0, 0); \
                    ATT_SB(); \
                    if (i + 2 < 8) va_[i & 1] = *(const bf16x8*)(Vh + 32 * ((i + 2) >> 1) * VP + 32 * ((i + 2) & 1)); \
                    if (i == 0) mx_ = __builtin_fmaxf(SN[0], __builtin_fmaxf(SN[1], SN[2]));   \
                    else if (i < 7) mx_ = max3f(mx_, SN[2 * i + 1], SN[2 * i + 2]); else mx_ = max2f(mx_, SN[15]); \
                    ATT_SB(); } \
            } else { \
                mx_ = __builtin_fmaxf(SN[0], __builtin_fmaxf(SN[1], SN[2])); \
                _Pragma("unroll") for (int i = 1; i < 7; ++i) mx_ = max3f(mx_, SN[2 * i + 1], SN[2 * i + 2]); \
                mx_ = max2f(mx_, SN[15]); } \
            mx_ = xhalf_max(mx_); \
            if (FIRST) { mref = bfround(mx_); mshf.x = (hi == 0) ? (pk2(-mref, 0.f) & 0xffffu) : 0u; _Pragma("unroll") for (int r = 0; r < 16; ++r) SN[r] -= mref; } \
            else if (__any(mx_ > THR)) { const float mn_ = bfround(mref + fmaxf(mx_, 0.f)); const float dl_ = mn_ - mref; mref = mn_; mshf.x = (hi == 0) ? (pk2(-mref, 0.f) & 0xffffu) : 0u; \
                const float f_ = __builtin_amdgcn_exp2f(-dl_); lsum *= f_; \
                _Pragma("unroll") for (int r = 0; r < 16; ++r) SN[r] -= dl_; \
                _Pragma("unroll") for (int d = 0; d < 4; ++d) o[d] = o[d] * f_; } \
            ATT_SB(); \
        } \
    } while (0)
    {
        const bool more0 = 1 < NT;
        ATT_STEP(sA, sB, 0, lds, 1, (more0 ? 1 : 0), 1, 1, 1);
        ATT_STEP(sB, sA, 1, lds, 0, (more0 ? 2 : 0), 1, 1, 1);
        asm volatile("s_waitcnt vmcnt(0)" ::: "memory");
        __syncthreads();
    }
    for (int kt = 1; kt < NT; ++kt) {
        const bool more = kt + 1 < NT; const int ksn = (kt + 1) & 1, vsn = (kt + 1) % 3;
        const unsigned char* Kt = lds + (kt & 1) * KT_BYTES;
        ATT_STEP(sA, sB, 2 * kt, Kt, 0, (more ? 1 : 0), kt + 1, ksn, vsn);
        ATT_STEP(sB, sA, 2 * kt + 1, Kt, 0, (more ? 2 : 0), kt + 1, ksn, vsn);
        asm volatile("s_waitcnt vmcnt(0)" ::: "memory");
        __syncthreads();
    }
    {
#pragma unroll
        for (int r = 0; r < 16; ++r) sB[r] = __builtin_amdgcn_exp2f(sB[r]);
        pw0.x = pk2(sB[0], sB[1]); pw0.y = pk2(sB[2], sB[3]); pw0.z = pk2(sB[4], sB[5]); pw0.w = pk2(sB[6], sB[7]);
        pw1.x = pk2(sB[8], sB[9]); pw1.y = pk2(sB[10], sB[11]); pw1.z = pk2(sB[12], sB[13]); pw1.w = pk2(sB[14], sB[15]);
        ATT_SB();
        ATT_ROWSUM(sB);
        ATT_PV(2 * NT - 1);
        __syncthreads();
    }
#undef ATT_ISSUE
#undef ATT_ISSUE1
#undef ATT_STEP
#undef ATT_QKCHAIN
#undef ATT_EXPPACK
#undef ATT_ROWSUM
#undef ATT_PV
#undef ATT_FIN4
    lsum += __shfl_xor(lsum, 32);
    const float inv = 1.f / lsum;
    if (qrow >= slo && qrow < shi) {
        bf16_t* op = mix + (size_t)qrow * 2048 + h * 128 + 4 * hi;
#pragma unroll
        for (int d = 0; d < 4; ++d)
#pragma unroll
            for (int rg = 0; rg < 4; ++rg) { u32x2 w; w.x = pk2(o[d][4 * rg] * inv, o[d][4 * rg + 1] * inv); w.y = pk2(o[d][4 * rg + 2] * inv, o[d][4 * rg + 3] * inv);
                *(u32x2*)(op + 32 * d + 8 * rg) = w; }
    }
}
__device__ __forceinline__ void phase(const Params& P, unsigned char* lds, int tid, int wave, int lane) {
    for (int w = blockIdx.x; w < 264; w += gridDim.x) {
        const int nu = (w < 256) ? 2 : 1;
#pragma nounroll
        for (int u = 0; u < nu; ++u) {
            int h, b; if (w < 256) { h = w & 7; const int j = w >> 3; b = (u == 0) ? 64 - j : j + 1; } else { h = w - 256; b = 0; }
            const int q0 = b ? NMETA + 256 * (b - 1) : 0, NT = b ? 4 * b + 1 : 1, shi = b ? q0 + 256 : NMETA;
            unit(P, lds, h, q0, NT, q0, shi, tid, wave, lane);
        }
    }
}
}

__device__ __forceinline__ void phase_rows1(const Params& P, int gw, int NGW, int lane) {
    const bf16_t* mixo = (const bf16_t*)(P.ws + WS_MIXO); bf16_t* hn2 = (bf16_t*)(P.ws + WS_HN2);
    for (int m = gw; m < SEQ; m += NGW) {
        const u32x2* mr = (const u32x2*)(mixo + (size_t)m * DM) + lane; const f32x4* xr = (const f32x4*)(P.x + (size_t)m * DM) + lane;
        const f32x4* g1 = (const f32x4*)P.g_mix_post + lane; const f32x4* g2 = (const f32x4*)P.g_mlp_pre + lane;
        f32x4 v[4]; float s = 0.f;
#pragma unroll
        for (int j = 0; j < 4; ++j) { const u32x2 u = mr[64 * j]; v[j] = (f32x4){bf_lo(u.x), bf_hi(u.x), bf_lo(u.y), bf_hi(u.y)}; s += (v[j].x * v[j].x + v[j].y * v[j].y) + (v[j].z * v[j].z + v[j].w * v[j].w); }
        const float r1 = rsqrtf(wave_sum(s) * (1.f / DM) + EPS); float s2 = 0.f;
#pragma unroll
        for (int j = 0; j < 4; ++j) { v[j] = xr[64 * j] + v[j] * r1 * g1[64 * j]; s2 += (v[j].x * v[j].x + v[j].y * v[j].y) + (v[j].z * v[j].z + v[j].w * v[j].w); }
        const float r2 = rsqrtf(wave_sum(s2) * (1.f / DM) + EPS);
        f32x4* orow = (f32x4*)(P.out + (size_t)m * DM) + lane; unsigned long long* o8 = (unsigned long long*)(hn2 + (size_t)m * DM) + lane;
#pragma unroll
        for (int j = 0; j < 4; ++j) { orow[64 * j] = v[j]; const f32x4 g = g2[64 * j];
            o8[64 * j] = (unsigned long long)pk2(v[j].x * r2 * g.x, v[j].y * r2 * g.y) | ((unsigned long long)pk2(v[j].z * r2 * g.z, v[j].w * r2 * g.w) << 32); }
    }
}
__device__ __forceinline__ void phase_rows2(const Params& P, int gw, int NGW, int lane) {
    const bf16_t* f = (const bf16_t*)(P.ws + WS_F);
    for (int m = gw; m < SEQ; m += NGW) {
        const u32x2* fr = (const u32x2*)(f + (size_t)m * DM) + lane; f32x4* orow = (f32x4*)(P.out + (size_t)m * DM) + lane; const f32x4* g1 = (const f32x4*)P.g_mlp_post + lane;
        f32x4 v[4]; float s = 0.f;
#pragma unroll
        for (int j = 0; j < 4; ++j) { const u32x2 u = fr[64 * j]; v[j] = (f32x4){bf_lo(u.x), bf_hi(u.x), bf_lo(u.y), bf_hi(u.y)}; s += (v[j].x * v[j].x + v[j].y * v[j].y) + (v[j].z * v[j].z + v[j].w * v[j].w); }
        const float r1 = rsqrtf(wave_sum(s) * (1.f / DM) + EPS);
#pragma unroll
        for (int j = 0; j < 4; ++j) orow[64 * j] = orow[64 * j] + v[j] * r1 * g1[64 * j];
    }
}

#define LAS __attribute__((address_space(3)))
#define XB_TMO      128
#define XB_XCNT(j)  (256  + 64 * (j))
#define XB_XSUB(j)  (1280 + 64 * (j))
#define XB_XGEN(j)  (2304 + 64 * (j))
#define XB_TOP      3328
#define XB_TOPGEN   3392
#define XCD_BAR_WORDS 3456
#define XB_SPIN_CAP (1u << 18)
__device__ __forceinline__ unsigned xb_ld(unsigned* p)              { return __hip_atomic_load(p, __ATOMIC_RELAXED, __HIP_MEMORY_SCOPE_AGENT); }
__device__ __forceinline__ unsigned xb_add(unsigned* p, unsigned v) { return __hip_atomic_fetch_add(p, v, __ATOMIC_RELAXED, __HIP_MEMORY_SCOPE_AGENT); }
__device__ __forceinline__ unsigned xb_xcc_id() { return (unsigned)__builtin_amdgcn_s_getreg((3 << 11) | 20) & 0xFu; }
#define XB_SPIN(cond, bar) do { unsigned _sp = 0; while (cond) { __builtin_amdgcn_s_sleep(1); \
    if ((++_sp & 255u) == 0u) { if (xb_ld(&(bar)[XB_TMO])) break; if (_sp > XB_SPIN_CAP) { atomicAdd(&(bar)[XB_TMO], 1u); break; } } } } while (0)
struct XcdBarrier { unsigned* bar; unsigned x; volatile LAS unsigned* st; };
__device__ __forceinline__ XcdBarrier xcd_barrier_post(unsigned* bar, volatile LAS unsigned* st) {
    XcdBarrier b; b.bar = bar; b.x = xb_xcc_id(); b.st = st;
    if (threadIdx.x == 0) (void)xb_add(&bar[XB_XCNT(b.x)], 1u);
    return b;
}
__device__ __forceinline__ void xcd_barrier_complete(unsigned* bar, unsigned x, unsigned& nloc, unsigned& nx) {
    const unsigned G = gridDim.x * gridDim.y * gridDim.z;
    unsigned sum, cnt, mine, sp = 0u;
    for (;;) {
        sum = 0u; cnt = 0u; mine = 0u;
#pragma unroll
        for (unsigned j = 0; j < 16; ++j) { const unsigned c = xb_ld(&bar[XB_XCNT(j)]); sum += c; cnt += (c > 0u) ? 1u : 0u; mine = (j == x) ? c : mine; }
        if (sum == G) break;
        __builtin_amdgcn_s_sleep(1);
        if ((++sp & 255u) == 0u) { if (xb_ld(&bar[XB_TMO])) break; if (sp > XB_SPIN_CAP) { atomicAdd(&bar[XB_TMO], 1u); break; } }
    }
    nloc = mine > 0u ? mine : 1u; nx = cnt > 0u ? cnt : 1u;
}
__device__ __forceinline__ void xcd_barrier(const XcdBarrier& b) {
    asm volatile("s_waitcnt vmcnt(0)" ::: "memory");
    __syncthreads();
    if (threadIdx.x == 0) {
        unsigned* bar = b.bar;
        __builtin_amdgcn_s_waitcnt(0);
        unsigned nloc = b.st[0], nx = b.st[1];
        if (nloc == 0u) { xcd_barrier_complete(bar, b.x, nloc, nx); b.st[0] = nloc; b.st[1] = nx; }
        const unsigned old = xb_add(&bar[XB_XSUB(b.x)], 1u);
        const unsigned gen = old / nloc;
        if (old + 1u == (gen + 1u) * nloc) {
            __builtin_amdgcn_fence(__ATOMIC_RELEASE, "agent");
            asm volatile("s_waitcnt vmcnt(0)" ::: "memory");
            const unsigned og = xb_add(&bar[XB_TOP], 1u);
            const unsigned tg = og / nx;
            if (og + 1u == (tg + 1u) * nx) xb_add(&bar[XB_TOPGEN], 1u);
            else XB_SPIN(xb_ld(&bar[XB_TOPGEN]) == tg, bar);
            __builtin_amdgcn_fence(__ATOMIC_ACQUIRE, "agent");
            xb_add(&bar[XB_XGEN(b.x)], 1u);
            asm volatile("s_waitcnt vmcnt(0)" ::: "memory");
        } else {
            XB_SPIN(xb_ld(&bar[XB_XGEN(b.x)]) == gen, bar);
            __builtin_amdgcn_fence(__ATOMIC_ACQUIRE, "agent");
            asm volatile("s_waitcnt vmcnt(0)" ::: "memory");
        }
    }
    __syncthreads();
}
constexpr int MISC_OFF = 160 * 1024 - 64;
constexpr size_t CTL_ZERO_BYTES = 65536;

__global__ void __launch_bounds__(512) hymba_fwd(Params P) {
    extern __shared__ __attribute__((aligned(16))) unsigned char lds[];
    PG8_LAS unsigned char* lds3 = (PG8_LAS unsigned char*)lds;
    unsigned char* ws = P.ws;
    const int lo = P.ph_lo, hi = P.ph_hi;
    const int G = gridDim.x;
#define IN(k) (lo <= (k) && (k) < hi)
#define SEAM(k) do { if (IN(k) && IN((k) + 1)) { xcd_barrier(xbar); } } while (0)
    { volatile LAS unsigned* misc = (volatile LAS unsigned*)(lds3 + MISC_OFF); if (threadIdx.x < 16) misc[threadIdx.x] = 0u; }
    __syncthreads();
    if (hi > NPHASE + 1000) cg::this_grid().sync();
    XcdBarrier xbar = xcd_barrier_post((unsigned*)(ws + 16384), (volatile LAS unsigned*)(lds3 + MISC_OFF));
#define TIDX() int tid = threadIdx.x; asm volatile("" : "+v"(tid)); const int lane = tid & 63, wave = __builtin_amdgcn_readfirstlane(tid >> 6); const int gw = blockIdx.x * 8 + wave, NGW = G * 8; (void)lane; (void)gw; (void)NGW
    typedef pg8::bf16_t bt;
    if (IN(0)) { TIDX(); phase0(P, lds, gw, NGW, wave, lane); } SEAM(0);
    if (IN(1)) {
        pg8::Gemm g{(const bt*)(ws + WS_HN), (const bt*)(ws + WS_WIN), MP, INWP, 1024, 1024, 1024}; pg8::StaticOrder S; S.init(MP, INWP, G, (int)blockIdx.x);
        pg8::EpiInProj E{(bt*)(ws + WS_LAT), (bt*)(ws + WS_Z), (bt*)(ws + WS_XBC), (float*)(ws + WS_DT), P.dt_bias};
        pg8::gemm_phase<pg8::EpiInProj, pg8::StaticOrder, true, true>(lds3, g, S, E);
        { TIDX(); __syncthreads();
          const int nextra = S.nwg % G;
          if (nextra > 0 && nextra < G) { if ((int)blockIdx.x >= nextra) { const int hw = ((int)blockIdx.x - nextra) * 8 + wave, nhw = (G - nextra) * 8;
                  convert_weights(P, lds, hw, nhw, wave, lane, W_ITEMS_IN, W_ITEMS_ALL); build_rope(P, hw, nhw, lane); } }
          else { convert_weights(P, lds, gw, NGW, wave, lane, W_ITEMS_IN, W_ITEMS_ALL); build_rope(P, gw, NGW, lane); } }
    } SEAM(1);
    if (IN(2)) { TIDX(); if (wave >= 4) __builtin_amdgcn_s_setprio(1); phase_ssd_states(P, lds, tid, wave, lane); if (wave >= 4) __builtin_amdgcn_s_setprio(0); } SEAM(2);
    if (IN(3)) { TIDX(); if (wave < 4) phase_scan(P, tid); else phase_latn(P, (int)blockIdx.x * 4 + (wave - 4), G * 4, lane); } SEAM(3);
    if (IN(4)) { TIDX(); if (wave >= 4) __builtin_amdgcn_s_setprio(1); phase_ssd_y(P, lds, tid, wave, lane); if (wave >= 4) __builtin_amdgcn_s_setprio(0); } SEAM(4);
    if (IN(5)) {
        { pg8::Gemm g{(const bt*)(ws + WS_LAT), (const bt*)(ws + WS_WQ), MP, QW, 384, LATW, 384}; pg8::StaticOrder S; S.init(MP, QW, G, (int)blockIdx.x);
          pg8::EpiBf16<0> E{(bt*)(ws + WS_Q), QW, QSCALE}; pg8::gemm_phase<pg8::EpiBf16<0>, pg8::StaticOrder, true, true>(lds3, g, S, E); }
        __syncthreads();
        { pg8::Gemm g{(const bt*)(ws + WS_LAT) + 384, (const bt*)(ws + WS_WK), MP, 1024, 256, LATW, 256}; pg8::StaticOrder S; S.init(MP, 1024, G, (int)((blockIdx.x + 120u) % (unsigned)G));
          pg8::EpiBf16<0> E{(bt*)(ws + WS_K), 1024, 1.f}; pg8::gemm_phase<pg8::EpiBf16<0>, pg8::StaticOrder, true, true>(lds3, g, S, E); }
        __syncthreads();
        { pg8::Gemm g{(const bt*)(ws + WS_WV), (const bt*)(ws + WS_LAT) + 384, 1024, MP, 256, 256, LATW}; pg8::StaticOrder S; S.init(1024, MP, G, (int)((blockIdx.x + 112u) % (unsigned)G));
          pg8::EpiBf16<0> E{(bt*)(ws + WS_VT), MP, 1.f}; pg8::gemm_phase<pg8::EpiBf16<0>, pg8::StaticOrder, true, true>(lds3, g, S, E); }
    } SEAM(5);
    if (IN(6)) { TIDX();
        if (wave >= 4) __builtin_amdgcn_s_setprio(1);
        att::phase(P, lds, tid, wave, lane);
        if (wave >= 4) __builtin_amdgcn_s_setprio(0);
    } SEAM(6);
    if (IN(7)) {
        pg8::Gemm g{(const bt*)(ws + WS_MIX) + (size_t)NMETA * 2048, (const bt*)(ws + WS_WOUT), SEQ, 1024, 2048, 2048, 2048}; pg8::StaticOrder S; S.init(SEQ, 1024, G, (int)blockIdx.x);
        pg8::EpiBf16<0> E{(bt*)(ws + WS_MIXO), 1024, 1.f}; pg8::gemm_phase<pg8::EpiBf16<0>, pg8::StaticOrder, false, true>(lds3, g, S, E);
    } SEAM(7);
    if (IN(8)) { TIDX(); phase_rows1(P, gw, NGW, lane); } SEAM(8);
    if (IN(9)) {
        pg8::Gemm g{(const bt*)(ws + WS_HN2), (const bt*)(ws + WS_WUP), SEQ, DFF, 1024, 1024, 1024}; pg8::StaticOrder S; S.init(SEQ, DFF, G, (int)blockIdx.x);
        pg8::EpiBf16<2> E{(bt*)(ws + WS_FF), DFF, 1.f}; pg8::gemm_phase<pg8::EpiBf16<2>, pg8::StaticOrder, true, true>(lds3, g, S, E);
    } SEAM(9);
    if (IN(10)) {
        pg8::Gemm g{(const bt*)(ws + WS_FF), (const bt*)(ws + WS_WDN), SEQ, 1024, DFF, DFF, DFF}; pg8::StaticOrder S; S.init(SEQ, 1024, G, (int)blockIdx.x);
        pg8::EpiBf16<0> E{(bt*)(ws + WS_F), 1024, 1.f}; pg8::gemm_phase<pg8::EpiBf16<0>, pg8::StaticOrder, false, true>(lds3, g, S, E);
    } SEAM(10);
    if (IN(11)) { TIDX(); phase_rows2(P, gw, NGW, lane); }
#undef IN
#undef SEAM
#undef TIDX
}

extern "C" void kernel_launch(void* const* d_in, const int* in_sizes, int n_in, void* d_out, int out_size, void* d_ws, size_t ws_size, hipStream_t stream) {
    static int grid = 0;
    if (grid == 0) {
        int dev = 0, cus = 0, per_cu = 0;
        (void)hipGetDevice(&dev); (void)hipDeviceGetAttribute(&cus, hipDeviceAttributeMultiprocessorCount, dev);
        if (hipFuncSetAttribute((const void*)hymba_fwd, hipFuncAttributeMaxDynamicSharedMemorySize, LDS_BYTES) != hipSuccess) { fprintf(stderr, "hipFuncSetAttribute failed\n"); }
        if (hipOccupancyMaxActiveBlocksPerMultiprocessor(&per_cu, (const void*)hymba_fwd, 512, LDS_BYTES) != hipSuccess || per_cu < 1) { fprintf(stderr, "occupancy query: %d\n", per_cu); per_cu = 1; }
        (void)hipGetLastError();
        grid = cus * 1;
        if (ws_size < 256 * MiB) { fprintf(stderr, "workspace too small: %zu\n", ws_size); grid = -1; }
    }
    if (grid < 0) return;
    Params p{};
    const float** pp = (const float**)&p;
    for (int i = 0; i < 20; ++i) pp[i] = (const float*)d_in[i];
    p.out = (float*)d_out; p.ws = (unsigned char*)d_ws;
    for (int j = 0; j < 32; ++j) p.invf[j] = (float)pow(10000.0, -(double)(2 * j) / 64.0);
#if ONE_LAUNCH
    p.ph_lo = 0; p.ph_hi = NPHASE;
    if (hipMemsetAsync(d_ws, 0, CTL_ZERO_BYTES, stream) != hipSuccess) { fprintf(stderr, "memset of the barrier words failed\n"); return; }
    void* args[] = {&p};
    hipError_t e = hipLaunchCooperativeKernel((const void*)hymba_fwd, dim3(grid), dim3(512), args, LDS_BYTES, stream);
    if (e != hipSuccess) fprintf(stderr, "cooperative launch failed: %s (grid %d)\n", hipGetErrorString(e), grid);
#else
    for (int ph = 0; ph < NPHASE; ++ph) { p.ph_lo = ph; p.ph_hi = ph + 1; hipLaunchKernelGGL(hymba_fwd, dim3(grid), dim3(512), LDS_BYTES, stream, p); }
#endif
}
```

```cpp
#include <hip/hip_runtime.h>
#include <hip/hip_cooperative_groups.h>
#include <cstdio>
#include <cstdint>
#include <cmath>
namespace cg = cooperative_groups;

#ifndef ONE_LAUNCH
#define ONE_LAUNCH 1
#endif

namespace pg8 {
#define PG8_LAS __attribute__((address_space(3)))
typedef unsigned short bf16_t;
typedef short bf16x8 __attribute__((ext_vector_type(8)));
typedef float f32x4 __attribute__((ext_vector_type(4)));
typedef unsigned u32x4 __attribute__((ext_vector_type(4)));
constexpr int BM = 256, BK = 64, HALF = 128, HTB = HALF * BK * 2, STAGE_BYTES = 8 * HTB, NXCD = 8, WGM = 8;

__host__ __device__ __forceinline__ int lds_byte(int r, int c) { const int st = (r >> 4) * 2 + (c >> 5), rr = r & 15, cc = c & 31, ob = rr * 64 + cc * 2; return st * 1024 + (ob ^ (((ob >> 9) & 1) << 5)); }
__host__ __device__ __forceinline__ void stage_rc(int b, int& R, int& C) { const int st = b / 1024, sb = b % 1024, swz = sb ^ (((sb >> 9) & 1) << 5); R = (st >> 1) * 16 + swz / 64; C = (st & 1) * 32 + (swz % 64) / 2; }
__host__ __device__ __forceinline__ int perm32(int rho) { const int n = rho >> 4, i = rho & 15; return 8 * (i >> 2) + 4 * n + (i & 3); }

struct Unit { int pm, pn; };
struct Gemm { const bf16_t* A; const bf16_t* Bt; int M, N, K, lda, ldb; };

struct StaticOrder {
    int nM, nN, nwg, G, c;
    __host__ __device__ void init(int M, int N, int G_, int c_) { nM = M / BM; nN = N / BM; nwg = nM * nN; G = G_; c = c_; }
    __host__ __device__ bool next(int i, Unit& u) const {
        const long L = (long)i * G + c; if (L >= nwg) return false;
        int wgid = (int)L; { const int q = nwg / NXCD, r = nwg % NXCD, xcd = wgid % NXCD, off = wgid / NXCD; wgid = (xcd < r ? xcd * (q + 1) : r * (q + 1) + (xcd - r) * q) + off; }
        const int nig = WGM * nN, gid = wgid / nig, fm = gid * WGM, gsz = (nM - fm) < WGM ? (nM - fm) : WGM;
        u.pm = fm + ((wgid % nig) % gsz); u.pn = (wgid % nig) / gsz; return true;
    }
    __device__ __forceinline__ void a_ready(const Unit&) const {}
    __device__ __forceinline__ void done(const Unit&) const {}
};

typedef float f32x2_t __attribute__((ext_vector_type(2))); typedef __bf16 bf16x2_t __attribute__((ext_vector_type(2)));
__device__ __forceinline__ unsigned cvt_pk_bf16(float lo, float hi) { f32x2_t v = {lo, hi}; bf16x2_t b = __builtin_convertvector(v, bf16x2_t); return __builtin_bit_cast(unsigned, b); }

template <int ACT  > struct EpiBf16 {
    static constexpr bool PERM = true, AFTER_DRAIN = false;
    bf16_t* O; int ldc; float scale;
    __device__ __forceinline__ void operator()(const f32x4 (&acc)[2][2][4][2], const Unit& u, int wr, int wc, int fr, int fq) const {
        const int row0 = u.pm * BM + wr * 64 + fr; const int col0 = u.pn * BM + wc * 32 + 8 * fq;
#pragma unroll
        for (int ai = 0; ai < 2; ++ai)
#pragma unroll
            for (int m = 0; m < 4; ++m) { bf16_t* rowp = O + (size_t)(row0 + ai * HALF + m * 16) * ldc + col0;
#pragma unroll
                for (int bj = 0; bj < 2; ++bj) { f32x4 v0 = acc[ai][bj][m][0], v1 = acc[ai][bj][m][1];
                    if (ACT == 2) {
#pragma unroll
                        for (int i = 0; i < 4; ++i) { float a = v0[i] > 0.f ? v0[i] : 0.f; v0[i] = a * a; float b = v1[i] > 0.f ? v1[i] : 0.f; v1[i] = b * b; } }
                    v0 = v0 * scale; v1 = v1 * scale; u32x4 w; w.x = cvt_pk_bf16(v0[0], v0[1]); w.y = cvt_pk_bf16(v0[2], v0[3]); w.z = cvt_pk_bf16(v1[0], v1[1]); w.w = cvt_pk_bf16(v1[2], v1[3]);
                    *(u32x4*)(rowp + bj * HALF) = w; } }
    }
};
struct EpiF32 {
    static constexpr bool PERM = true, AFTER_DRAIN = false;
    float* O; int ldc;
    __device__ __forceinline__ void operator()(const f32x4 (&acc)[2][2][4][2], const Unit& u, int wr, int wc, int fr, int fq) const {
        const int row0 = u.pm * BM + wr * 64 + fr; const int col0 = u.pn * BM + wc * 32 + 8 * fq;
#pragma unroll
        for (int ai = 0; ai < 2; ++ai)
#pragma unroll
            for (int m = 0; m < 4; ++m) { float* rowp = O + (size_t)(row0 + ai * HALF + m * 16) * ldc + col0;
#pragma unroll
                for (int bj = 0; bj < 2; ++bj) { *(f32x4*)(rowp + bj * HALF) = acc[ai][bj][m][0]; *(f32x4*)(rowp + bj * HALF + 4) = acc[ai][bj][m][1]; } }
    }
};
struct EpiInProj {
    static constexpr bool PERM = true, AFTER_DRAIN = false;
    bf16_t* lat; bf16_t* z; bf16_t* xbc; float* dt; const float* dt_bias;
    __device__ __forceinline__ void operator()(const f32x4 (&acc)[2][2][4][2], const Unit& u, int wr, int wc, int fr, int fq) const {
        const int row0 = u.pm * BM + wr * 64 + fr; const int colb = u.pn * BM + wc * 32 + 8 * fq;
#pragma unroll
        for (int ai = 0; ai < 2; ++ai)
#pragma unroll
            for (int m = 0; m < 4; ++m) { const size_t row = (size_t)(row0 + ai * HALF + m * 16);
#pragma unroll
                for (int bj = 0; bj < 2; ++bj) { const int col = colb + bj * HALF; const f32x4 v0 = acc[ai][bj][m][0], v1 = acc[ai][bj][m][1];
                    if (col < 3264) {
                        u32x4 w; w.x = cvt_pk_bf16(v0[0], v0[1]); w.y = cvt_pk_bf16(v0[2], v0[3]); w.z = cvt_pk_bf16(v1[0], v1[1]); w.w = cvt_pk_bf16(v1[2], v1[3]);
                        bf16_t* p;
                        if (col < 704) p = lat + row * 704 + col; else if (col < 1728) p = z + row * 1024 + (col - 704); else p = xbc + row * 1536 + (col - 1728);
                        *(u32x4*)p = w;
                    } else if (col < 3280) {
                        const int c0 = col - 3264; f32x4 o0, o1;
#pragma unroll
                        for (int i = 0; i < 4; ++i) { float a = v0[i] + dt_bias[c0 + i]; o0[i] = fmaxf(a, 0.f) + log1pf(__expf(-fabsf(a))); float b = v1[i] + dt_bias[c0 + 4 + i]; o1[i] = fmaxf(b, 0.f) + log1pf(__expf(-fabsf(b))); }
                        *(f32x4*)(dt + row * 16 + c0) = o0; *(f32x4*)(dt + row * 16 + c0 + 4) = o1;
                    } } }
    }
};

template <class Epi, class Sched, bool ALIGN_EPI = false, bool SP2 = false>
__device__ __forceinline__ void gemm_phase(PG8_LAS unsigned char* lds, const Gemm g, const Sched& S, const Epi& E) {
    int tid = threadIdx.x; asm volatile("" : "+v"(tid));
    const int wid = __builtin_amdgcn_readfirstlane(tid >> 6), lane = tid & 63, wr = wid >> 2, wc = wid & 3, fr = lane & 15, fq = lane >> 4;
    const int K = g.K, nt = K / BK;
    unsigned voffA[2], voffB[2];
#pragma unroll
    for (int i = 0; i < 2; ++i) { int R, C; stage_rc(tid * 16 + i * 8192, R, C); const int Rb = Epi::PERM ? ((R & ~31) + perm32(R & 31)) : R;
        voffA[i] = (unsigned)(R * g.lda + C) * 2u; voffB[i] = (unsigned)(Rb * g.ldb + C) * 2u; }
    const size_t kstep = (size_t)(BK * 2);
    const size_t hstepA = (size_t)HALF * g.lda * 2, hstepB = (size_t)HALF * g.ldb * 2;
    const size_t tstepA = 2 * hstepA, tstepB = 2 * hstepB;
    const unsigned ldsw = (unsigned)wid * 1024u;
    const int aoff = lds_byte(wr * 64 + fr, fq * 8), boff = lds_byte(wc * 32 + fr, fq * 8);
#define PG8_SA(b, h) (((b) * 2 + (h)) * HTB)
#define PG8_SB(b, h) ((4 + (b) * 2 + (h)) * HTB)
#define PG8_STAGE(bufoff, gbase, voff) do { _Pragma("unroll") for (int _i = 0; _i < 2; ++_i) \
        __builtin_amdgcn_global_load_lds((const unsigned*)((const char*)(gbase) + (voff)[_i]), (PG8_LAS unsigned*)(lds + (bufoff) + ldsw + _i * 8192), 16, 0, 0); } while (0)
#define PG8_LDA(dst, b, h) do { _Pragma("unroll") for (int m = 0; m < 4; ++m) _Pragma("unroll") for (int k = 0; k < 2; ++k) dst[m][k] = *(const PG8_LAS bf16x8*)(lds + PG8_SA(b, h) + aoff + m * 2048 + k * 1024); } while (0)
#define PG8_LDB(dst, b, h) do { _Pragma("unroll") for (int n = 0; n < 2; ++n) _Pragma("unroll") for (int k = 0; k < 2; ++k) dst[n][k] = *(const PG8_LAS bf16x8*)(lds + PG8_SB(b, h) + boff + n * 2048 + k * 1024); } while (0)
#define PG8_MMA(ai, bj, At, Bt) do { __builtin_amdgcn_s_setprio(1); _Pragma("unroll") for (int m = 0; m < 4; ++m) _Pragma("unroll") for (int n = 0; n < 2; ++n) _Pragma("unroll") for (int k = 0; k < 2; ++k) \
        acc[ai][bj][m][n] = __builtin_amdgcn_mfma_f32_16x16x32_bf16(Bt[n][k], At[m][k], acc[ai][bj][m][n], 0, 0, 0); __builtin_amdgcn_s_setprio(0); } while (0)
#define PG8_WAIT_V(n) asm volatile("s_waitcnt vmcnt(" #n ")" ::: "memory")
#define PG8_WAIT_L(n) asm volatile("s_waitcnt lgkmcnt(" #n ")" ::: "memory")
#define PG8_BAR __builtin_amdgcn_s_barrier()
#define PG8_SCHED __builtin_amdgcn_sched_barrier(0)
    Unit cur, nxt; int ui = 0;
    if (!S.next(0, cur)) return;
    f32x4 acc[2][2][4][2];
#pragma unroll
    for (int a = 0; a < 2; ++a)
#pragma unroll
        for (int b = 0; b < 2; ++b)
#pragma unroll
            for (int m = 0; m < 4; ++m)
#pragma unroll
                for (int n = 0; n < 2; ++n) acc[a][b][m][n] = (f32x4){0.f, 0.f, 0.f, 0.f};
    bf16x8 At[4][2], B0[2][2], B1[2][2];
    const char* cA = (const char*)g.A + (size_t)cur.pm * tstepA; const char* cB = (const char*)g.Bt + (size_t)cur.pn * tstepB;
    S.a_ready(cur);
    if constexpr (SP2) {
        PG8_STAGE(PG8_SB(0, 0), cB, voffB); PG8_STAGE(PG8_SB(0, 1), cB + hstepB, voffB); PG8_STAGE(PG8_SA(0, 0), cA, voffA); PG8_STAGE(PG8_SA(0, 1), cA + hstepA, voffA);
        if (wr == 1) PG8_BAR;
        PG8_WAIT_V(2); PG8_BAR;
        PG8_STAGE(PG8_SB(1, 0), cB + kstep, voffB); PG8_STAGE(PG8_SA(1, 0), cA + kstep, voffA); PG8_STAGE(PG8_SB(1, 1), cB + hstepB + kstep, voffB);
        PG8_WAIT_V(6); PG8_BAR;
    } else {
        PG8_STAGE(PG8_SB(0, 0), cB, voffB); PG8_STAGE(PG8_SA(0, 0), cA, voffA); PG8_STAGE(PG8_SB(0, 1), cB + hstepB, voffB); PG8_STAGE(PG8_SA(0, 1), cA + hstepA, voffA);
        if (wr == 1) PG8_BAR;
        PG8_WAIT_V(4); PG8_BAR;
        PG8_STAGE(PG8_SB(1, 0), cB + kstep, voffB); PG8_STAGE(PG8_SA(1, 0), cA + kstep, voffA); PG8_STAGE(PG8_SB(1, 1), cB + hstepB + kstep, voffB);
        PG8_WAIT_V(6); PG8_BAR;
    }
    for (;;) {
        const bool has_next = S.next(ui + 1, nxt);
        const char* nA = has_next ? (const char*)g.A + (size_t)nxt.pm * tstepA : cA; const char* nB = has_next ? (const char*)g.Bt + (size_t)nxt.pn * tstepB : cB;
        for (int t = 0; t < nt; t += 2) {
            const bool last = (t == nt - 2);
            const char* a1 = cA + (size_t)(t + 1) * kstep;
            const char* a2 = last ? nA : cA + (size_t)(t + 2) * kstep; const char* b2 = last ? nB : cB + (size_t)(t + 2) * kstep;
            const char* a3 = a2 + kstep; const char* b3 = b2 + kstep;
            if (last && has_next) S.a_ready(nxt);
            if constexpr (SP2) {
            PG8_LDB(B0, 0, 0); PG8_LDB(B1, 0, 1); PG8_SCHED; PG8_LDA(At, 0, 0); PG8_STAGE(PG8_SA(1, 1), a1 + hstepA, voffA);
            PG8_WAIT_V(8); PG8_WAIT_L(0); PG8_BAR; PG8_MMA(0, 0, At, B0); PG8_MMA(0, 1, At, B1); PG8_BAR; PG8_SCHED;
            PG8_LDA(At, 0, 1); PG8_STAGE(PG8_SB(0, 0), b2, voffB); PG8_STAGE(PG8_SB(0, 1), b2 + hstepB, voffB); PG8_STAGE(PG8_SA(0, 0), a2, voffA);
            PG8_WAIT_V(8); PG8_WAIT_L(0); PG8_BAR; PG8_MMA(1, 0, At, B0); PG8_MMA(1, 1, At, B1); PG8_BAR; PG8_SCHED;
            PG8_LDB(B0, 1, 0); PG8_LDB(B1, 1, 1); PG8_SCHED; PG8_LDA(At, 1, 0); PG8_STAGE(PG8_SA(0, 1), a2 + hstepA, voffA);
            PG8_WAIT_V(8); PG8_WAIT_L(0); PG8_BAR; PG8_MMA(0, 0, At, B0); PG8_MMA(0, 1, At, B1); PG8_BAR; PG8_SCHED;
            PG8_LDA(At, 1, 1); PG8_STAGE(PG8_SB(1, 0), b3, voffB); PG8_STAGE(PG8_SB(1, 1), b3 + hstepB, voffB); PG8_STAGE(PG8_SA(1, 0), a3, voffA);
            PG8_WAIT_V(8); PG8_WAIT_L(0); PG8_BAR; PG8_MMA(1, 0, At, B0); PG8_MMA(1, 1, At, B1); PG8_BAR; PG8_SCHED;
            } else {
            PG8_LDB(B0, 0, 0); PG8_SCHED; PG8_LDA(At, 0, 0); PG8_STAGE(PG8_SA(1, 1), a1 + hstepA, voffA);
            PG8_WAIT_L(8); PG8_BAR; PG8_WAIT_L(0); PG8_MMA(0, 0, At, B0); PG8_BAR; PG8_SCHED;
            PG8_LDB(B1, 0, 1); PG8_STAGE(PG8_SB(0, 0), b2, voffB);
            PG8_BAR; PG8_WAIT_L(0); PG8_MMA(0, 1, At, B1); PG8_BAR;
            PG8_LDA(At, 0, 1); PG8_STAGE(PG8_SA(0, 0), a2, voffA);
            PG8_BAR; PG8_WAIT_L(0); PG8_MMA(1, 0, At, B0); PG8_BAR; PG8_SCHED;
            PG8_STAGE(PG8_SB(0, 1), b2 + hstepB, voffB);
            PG8_WAIT_V(6); PG8_BAR; PG8_MMA(1, 1, At, B1); PG8_BAR;
            PG8_LDB(B0, 1, 0); PG8_SCHED; PG8_LDA(At, 1, 0); PG8_STAGE(PG8_SA(0, 1), a2 + hstepA, voffA);
            PG8_WAIT_L(8); PG8_BAR; PG8_WAIT_L(0); PG8_MMA(0, 0, At, B0); PG8_BAR; PG8_SCHED;
            PG8_LDB(B1, 1, 1); PG8_STAGE(PG8_SB(1, 0), b3, voffB);
            PG8_BAR; PG8_WAIT_L(0); PG8_MMA(0, 1, At, B1); PG8_BAR;
            PG8_LDA(At, 1, 1); PG8_STAGE(PG8_SA(1, 0), a3, voffA);
            PG8_BAR; PG8_WAIT_L(0); PG8_MMA(1, 0, At, B0); PG8_BAR; PG8_SCHED;
            PG8_STAGE(PG8_SB(1, 1), b3 + hstepB, voffB);
            PG8_WAIT_V(6); PG8_BAR; PG8_MMA(1, 1, At, B1); PG8_BAR;
            }
        }
        if constexpr (ALIGN_EPI) { if (wr == 0) PG8_BAR; }
        if constexpr (!Epi::AFTER_DRAIN) { E(acc, cur, wr, wc, fr, fq); S.done(cur); }
        if (!has_next) break;
#pragma unroll
        for (int a = 0; a < 2; ++a)
#pragma unroll
            for (int b = 0; b < 2; ++b)
#pragma unroll
                for (int m = 0; m < 4; ++m)
#pragma unroll
                    for (int n = 0; n < 2; ++n) acc[a][b][m][n] = (f32x4){0.f, 0.f, 0.f, 0.f};
        cur = nxt; cA = nA; cB = nB; ++ui;
        if constexpr (ALIGN_EPI) { if (wr == 1) PG8_BAR; }
    }
    PG8_WAIT_V(0);
    if constexpr (!ALIGN_EPI) { if (wr == 0) PG8_BAR; }
    PG8_BAR;
#undef PG8_SA
#undef PG8_SB
#undef PG8_STAGE
#undef PG8_LDA
#undef PG8_LDB
#undef PG8_MMA
#undef PG8_WAIT_V
#undef PG8_WAIT_L
#undef PG8_BAR
#undef PG8_SCHED
}
}

typedef unsigned short bf16_t;
typedef short bf16x8 __attribute__((ext_vector_type(8)));
typedef float f32x16 __attribute__((ext_vector_type(16)));
typedef float f32x4 __attribute__((ext_vector_type(4)));
typedef unsigned u32x4 __attribute__((ext_vector_type(4)));
typedef unsigned u32x2 __attribute__((ext_vector_type(2)));

constexpr int DM = 1024, SEQ = 16384, NMETA = 16, L = SEQ + NMETA  , MP = 16640  ;
constexpr int INW = 3280, INWP = 3328, LATW = 704, QW = 1536, XBCW = 1536, DFF = 4096;
constexpr int NCH = 129;
constexpr float EPS = 1e-6f;
constexpr float QSCALE = 0.07216878364870322f * 1.4426950408889634f;
constexpr size_t MiB = 1u << 20;
constexpr size_t WS_WIN = 1 * MiB, WS_WQ = WS_WIN + (size_t)INWP * 1024 * 2, WS_WK = WS_WQ + (size_t)1536 * 384 * 2, WS_WV = WS_WK + (size_t)1024 * 256 * 2;
constexpr size_t WS_WOUT = 10 * MiB, WS_WUP = 14 * MiB, WS_WDN = 22 * MiB;
constexpr size_t WS_DT = 30 * MiB, WS_CDEC = 31 * MiB + 512 * 1024, WS_ROPE = 32 * MiB;
constexpr size_t WS_MIX = 37 * MiB;
constexpr size_t WS_HN = 37 * MiB;
constexpr size_t WS_LAT = 102 * MiB;
constexpr size_t WS_Z = 124 * MiB + 512 * 1024;
constexpr size_t WS_XBC = 157 * MiB;
constexpr size_t WS_ST = 205 * MiB + 768 * 1024;
constexpr size_t WS_KR = 253 * MiB;
constexpr size_t WS_BCONV = 238 * MiB + 512 * 1024;
static_assert(WS_BCONV + (size_t)MP * 256 * 2 <= WS_KR, "bconv");
constexpr size_t WS_Q = WS_Z;
constexpr size_t WS_K = 173 * MiB + 256 * 1024;
constexpr size_t WS_VT = 205 * MiB + 768 * 1024;
constexpr size_t WS_MIXO = 102 * MiB;
constexpr size_t WS_HN2 = 224 * MiB;
constexpr size_t WS_FF = 37 * MiB;
constexpr size_t WS_F = 165 * MiB;
static_assert(WS_WV + (size_t)1024 * 256 * 2 <= WS_WOUT, "w");
static_assert(WS_ROPE + (size_t)L * 32 * 8 <= WS_MIX, "rope");
static_assert(WS_MIX + (size_t)MP * 2048 * 2 <= WS_LAT, "mix");
static_assert(WS_LAT + (size_t)MP * 704 * 2 <= WS_Z, "lat");
static_assert(WS_Z + (size_t)MP * 1024 * 2 <= WS_XBC, "z");
static_assert(WS_XBC + (size_t)MP * 1536 * 2 <= WS_ST, "xbc");
static_assert(WS_ST + (size_t)NCH * 131072 * 2 <= WS_KR, "st");
static_assert(WS_KR + (size_t)MP * 64 * 2 <= 256 * MiB, "kr");
static_assert(WS_Q + (size_t)MP * 1536 * 2 <= WS_K && WS_K + (size_t)MP * 1024 * 2 <= WS_VT && WS_VT + (size_t)1024 * MP * 2 <= WS_KR, "qkv");
static_assert(WS_MIXO + (size_t)SEQ * 1024 * 4 <= WS_HN2 && WS_FF + (size_t)SEQ * 4096 * 2 <= WS_F && WS_F + (size_t)SEQ * 1024 * 4 <= 256 * MiB, "tail");

constexpr int LDS_BYTES = 160 * 1024;
constexpr int NPHASE = 12;

struct Params {
    const float *x, *meta, *g_mix_pre, *w_in, *g_qa, *w_q_up, *g_kva, *w_kv_up, *conv_w, *conv_b, *dt_bias, *a_log, *d_skip, *g_ssm, *w_out, *g_mix_post, *g_mlp_pre, *w_up, *w_dn, *g_mlp_post;
    float* out; unsigned char* ws;
    float invf[32];
    int ph_lo, ph_hi;
};

__device__ __forceinline__ float bf_lo(unsigned u) { return __uint_as_float(u << 16); }
__device__ __forceinline__ float bf_hi(unsigned u) { return __uint_as_float(u & 0xffff0000u); }
__device__ __forceinline__ float bf2f(bf16_t b) { return __uint_as_float(((unsigned)b) << 16); }
__device__ __forceinline__ unsigned pk2(float lo, float hi) { return pg8::cvt_pk_bf16(lo, hi); }
__device__ __forceinline__ bf16_t f2bf(float f) { return (bf16_t)(pk2(f, 0.f) & 0xffffu); }
__device__ __forceinline__ float wave_sum(float v) {
#pragma unroll
    for (int o = 1; o < 64; o <<= 1) v += __shfl_xor(v, o);
    return v;
}
__device__ __forceinline__ float silu(float v) { return v * __builtin_amdgcn_rcpf(1.f + __expf(-v)); }

__device__ __forceinline__ void p0_transpose_item(const float* W, int K, int ldsrc, bf16_t* WT, float* scr, int k0, int n0, int scol0, int nvalid, int lane) {
    const bool ok = (n0 + (lane & 31)) < nvalid;
#pragma unroll 8
    for (int i = 0; i < 32; ++i) { const int kk = 2 * i + (lane >> 5); scr[kk * 33 + (lane & 31)] = ok ? W[(size_t)(k0 + kk) * ldsrc + scol0 + (lane & 31)] : 0.f; }
    __builtin_amdgcn_s_waitcnt(0); asm volatile("" ::: "memory");
    const int c = lane & 7;
#pragma unroll
    for (int j = 0; j < 4; ++j) { const int n = (lane >> 3) + 8 * j; const float* s = scr + (8 * c) * 33 + n;
        u32x4 o; o.x = pk2(s[0 * 33], s[1 * 33]); o.y = pk2(s[2 * 33], s[3 * 33]); o.z = pk2(s[4 * 33], s[5 * 33]); o.w = pk2(s[6 * 33], s[7 * 33]);
        *(u32x4*)(WT + (size_t)(n0 + n) * K + k0 + 8 * c) = o; }
    __builtin_amdgcn_s_waitcnt(0); asm volatile("" ::: "memory");
}

__device__ __forceinline__ void sincos_acc(float a, float& c, float& s) {
    const double x = (double)a; const double k = rint(x * 0.63661977236758134308);
    const double r = fma(-k, 1.57079632679489661923, x), r2 = r * r;
    double sp = -2.5052108385441718775e-8; sp = sp * r2 + 2.7557319223985890653e-6; sp = sp * r2 - 1.9841269841269841270e-4; sp = sp * r2 + 8.3333333333333333333e-3; sp = sp * r2 - 1.6666666666666666667e-1; sp = r + r * r2 * sp;
    double cp = 2.0876756987868098979e-9; cp = cp * r2 - 2.7557319223985890653e-7; cp = cp * r2 + 2.4801587301587301587e-5; cp = cp * r2 - 1.3888888888888888889e-3; cp = cp * r2 + 4.1666666666666666667e-2; cp = cp * r2 - 0.5; cp = 1.0 + r2 * cp;
    const int q = ((int)k) & 3;
    const double sv = (q == 0) ? sp : (q == 1) ? cp : (q == 2) ? -sp : -cp;
    const double cv = (q == 0) ? cp : (q == 1) ? -sp : (q == 2) ? -cp : sp;
    c = (float)cv; s = (float)sv;
}

__device__ __forceinline__ void convert_weights(const Params& P, unsigned char* lds, int gw, int NGW, int wave, int lane, int it_lo, int it_hi) {
    unsigned char* ws = P.ws;
    float* scr = (float*)(lds + wave * 8704);
    constexpr int I_IN = 16 * 104, I_Q = 6 * 48, I_K = 4 * 32, I_V = 4 * 32, I_O = 32 * 32, I_U = 16 * 128, I_D = 64 * 32;
    for (int it = it_lo + gw; it < it_hi; it += NGW) {
        int r = it;
        if (r < I_IN) { const int kb = r / 104, nb = r % 104; p0_transpose_item(P.w_in, 1024, INW, (bf16_t*)(ws + WS_WIN), scr, kb * 64, nb * 32, nb * 32, INW, lane); continue; } r -= I_IN;
        if (r < I_Q) { const int kb = r / 48, nb = r % 48; p0_transpose_item(P.w_q_up, 384, 1536, (bf16_t*)(ws + WS_WQ), scr, kb * 64, nb * 32, nb * 32, 1536, lane); continue; } r -= I_Q;
        if (r < I_K) { const int kb = r / 32, nb = r % 32, n0 = nb * 32; p0_transpose_item(P.w_kv_up, 256, 2048, (bf16_t*)(ws + WS_WK), scr, kb * 64, n0, 256 * (n0 >> 7) + (n0 & 127), 1024, lane); continue; } r -= I_K;
        if (r < I_V) { const int kb = r / 32, nb = r % 32, n0 = nb * 32; p0_transpose_item(P.w_kv_up, 256, 2048, (bf16_t*)(ws + WS_WV), scr, kb * 64, n0, 256 * (n0 >> 7) + 128 + (n0 & 127), 1024, lane); continue; } r -= I_V;
        if (r < I_O) { const int kb = r / 32, nb = r % 32; p0_transpose_item(P.w_out, 2048, 1024, (bf16_t*)(ws + WS_WOUT), scr, kb * 64, nb * 32, nb * 32, 1024, lane); continue; } r -= I_O;
        if (r < I_U) { const int kb = r / 128, nb = r % 128; p0_transpose_item(P.w_up, 1024, 4096, (bf16_t*)(ws + WS_WUP), scr, kb * 64, nb * 32, nb * 32, 4096, lane); continue; } r -= I_U;
        { const int kb = r / 32, nb = r % 32; p0_transpose_item(P.w_dn, 4096, 1024, (bf16_t*)(ws + WS_WDN), scr, kb * 64, nb * 32, nb * 32, 1024, lane); }
    }
}
constexpr int W_ITEMS_IN = 16 * 104, W_ITEMS_ALL = 16 * 104 + 6 * 48 + 4 * 32 + 4 * 32 + 32 * 32 + 16 * 128 + 64 * 32;
__device__ __forceinline__ void phase0(const Params& P, unsigned char* lds, int gw, int NGW, int wave, int lane) {
    unsigned char* ws = P.ws;
    convert_weights(P, lds, gw, NGW, wave, lane, 0, W_ITEMS_IN);
    bf16_t* hn = (bf16_t*)(ws + WS_HN);
    for (int m = gw; m < MP; m += NGW) {
        unsigned long long* o8 = (unsigned long long*)(hn + (size_t)m * DM) + lane;
        if (m >= L) {
#pragma unroll
            for (int j = 0; j < 4; ++j) o8[64 * j] = 0ull;
            continue; }
        const float* xrow = (m < NMETA) ? (P.meta + (size_t)m * DM) : (P.x + (size_t)(m - NMETA) * DM);
        const f32x4* xr = (const f32x4*)xrow + lane; const f32x4* gr = (const f32x4*)P.g_mix_pre + lane;
        f32x4 v[4]; float s = 0.f;
#pragma unroll
        for (int j = 0; j < 4; ++j) { v[j] = xr[64 * j]; s += (v[j].x * v[j].x + v[j].y * v[j].y) + (v[j].z * v[j].z + v[j].w * v[j].w); }
        const float rstd = rsqrtf(wave_sum(s) * (1.f / DM) + EPS);
#pragma unroll
        for (int j = 0; j < 4; ++j) { const f32x4 g = gr[64 * j];
            o8[64 * j] = (unsigned long long)pk2(v[j].x * rstd * g.x, v[j].y * rstd * g.y) | ((unsigned long long)pk2(v[j].z * rstd * g.z, v[j].w * rstd * g.w) << 32); }
    }
}
__device__ __forceinline__ void build_rope(const Params& P, int gw, int NGW, int lane) {
    float2* rope = (float2*)(P.ws + WS_ROPE);
    for (int i = gw * 64 + lane; i < L * 32; i += NGW * 64) { const int pos = i >> 5, j = i & 31; const float a = (float)pos * P.invf[j]; float c, s; sincos_acc(a, c, s); rope[i] = make_float2(c, s); }
}

__device__ __forceinline__ void phase_latn(const Params& P, int gw, int NGW, int lane) {
    bf16_t* lat = (bf16_t*)(P.ws + WS_LAT); bf16_t* kr = (bf16_t*)(P.ws + WS_KR); const float2* rope = (const float2*)(P.ws + WS_ROPE);
    for (int m0 = 2 * gw; m0 < MP; m0 += 2 * NGW) {
        float q[2][6], kv[2][4], x1[2], x2[2];
#pragma unroll
        for (int t = 0; t < 2; ++t) { const bf16_t* row = lat + (size_t)(m0 + t) * LATW;
#pragma unroll
            for (int i = 0; i < 6; ++i) q[t][i] = bf2f(row[lane + 64 * i]);
#pragma unroll
            for (int i = 0; i < 4; ++i) kv[t][i] = bf2f(row[384 + lane + 64 * i]);
            x1[t] = 0.f; x2[t] = 0.f; if (lane < 32) { x1[t] = bf2f(row[640 + lane]); x2[t] = bf2f(row[672 + lane]); } }
#pragma unroll
        for (int t = 0; t < 2; ++t) { const int m = m0 + t; bf16_t* row = lat + (size_t)m * LATW;
            float sq = 0.f, sk = 0.f;
#pragma unroll
            for (int i = 0; i < 6; ++i) sq += q[t][i] * q[t][i];
#pragma unroll
            for (int i = 0; i < 4; ++i) sk += kv[t][i] * kv[t][i];
            const float rq = rsqrtf(wave_sum(sq) * (1.f / 384.f) + EPS), rk = rsqrtf(wave_sum(sk) * (1.f / 256.f) + EPS);
#pragma unroll
            for (int i = 0; i < 6; ++i) row[lane + 64 * i] = f2bf(q[t][i] * rq * P.g_qa[lane + 64 * i]);
#pragma unroll
            for (int i = 0; i < 4; ++i) row[384 + lane + 64 * i] = f2bf(kv[t][i] * rk * P.g_kva[lane + 64 * i]);
            if (lane < 32) {
                float o1 = 0.f, o2 = 0.f;
                if (m < L) { const float2 cs = rope[m * 32 + lane]; o1 = x1[t] * cs.x - x2[t] * cs.y; o2 = x2[t] * cs.x + x1[t] * cs.y; }
                kr[(size_t)m * 64 + lane] = f2bf(o1); kr[(size_t)m * 64 + 32 + lane] = f2bf(o2);
            } }
    }
}

__device__ __forceinline__ void conv8(const bf16_t* xbc, const float* cw, const float* cb, int t, int ch, float (&o)[8]) {
    u32x4 u[4]; f32x4 w0[4], w1[4];
#pragma unroll
    for (int k = 0; k < 4; ++k) { const int tt = t - 3 + k, tc = tt < 0 ? 0 : tt;
        u[k] = *(const u32x4*)(xbc + (size_t)tc * XBCW + ch); w0[k] = *(const f32x4*)(cw + k * XBCW + ch); w1[k] = *(const f32x4*)(cw + k * XBCW + ch + 4); }
    { const f32x4 b0 = *(const f32x4*)(cb + ch), b1 = *(const f32x4*)(cb + ch + 4); o[0] = b0.x; o[1] = b0.y; o[2] = b0.z; o[3] = b0.w; o[4] = b1.x; o[5] = b1.y; o[6] = b1.z; o[7] = b1.w; }
#pragma unroll
    for (int k = 0; k < 4; ++k) { const float mk = (t - 3 + k >= 0) ? 1.f : 0.f; const f32x4 a = w0[k] * mk, b = w1[k] * mk;
        o[0] += a.x * bf_lo(u[k].x); o[1] += a.y * bf_hi(u[k].x); o[2] += a.z * bf_lo(u[k].y); o[3] += a.w * bf_hi(u[k].y);
        o[4] += b.x * bf_lo(u[k].z); o[5] += b.y * bf_hi(u[k].z); o[6] += b.z * bf_lo(u[k].w); o[7] += b.w * bf_hi(u[k].w); }
#pragma unroll
    for (int i = 0; i < 8; ++i) o[i] = silu(o[i]);
}
struct ConvW { f32x4 w0[4], w1[4], b0, b1; };
__device__ __forceinline__ void convw_load(ConvW& W, const float* cw, const float* cb, int ch) {
#pragma unroll
    for (int k = 0; k < 4; ++k) { W.w0[k] = *(const f32x4*)(cw + k * XBCW + ch); W.w1[k] = *(const f32x4*)(cw + k * XBCW + ch + 4); }
    W.b0 = *(const f32x4*)(cb + ch); W.b1 = *(const f32x4*)(cb + ch + 4);
}
template <int NR> __device__ __forceinline__ void conv_rows_load(const bf16_t* xbc, int t0, int ch, u32x4 (&u)[NR + 3]) {
#pragma unroll
    for (int i = 0; i < NR + 3; ++i) { const int tt = t0 - 3 + i, tc = tt < 0 ? 0 : tt; const u32x4 v = *(const u32x4*)(xbc + (size_t)tc * XBCW + ch); u[i] = (tt >= 0) ? v : (u32x4){0u, 0u, 0u, 0u}; }
}
template <int NR> __device__ __forceinline__ void conv_row_out(const ConvW& W, const u32x4 (&u)[NR + 3], int r, float (&o)[8]) {
    o[0] = W.b0.x; o[1] = W.b0.y; o[2] = W.b0.z; o[3] = W.b0.w; o[4] = W.b1.x; o[5] = W.b1.y; o[6] = W.b1.z; o[7] = W.b1.w;
#pragma unroll
    for (int k = 0; k < 4; ++k) { const u32x4 v = u[r + k]; const f32x4 a = W.w0[k], b = W.w1[k];
        o[0] += a.x * bf_lo(v.x); o[1] += a.y * bf_hi(v.x); o[2] += a.z * bf_lo(v.y); o[3] += a.w * bf_hi(v.y);
        o[4] += b.x * bf_lo(v.z); o[5] += b.y * bf_hi(v.z); o[6] += b.z * bf_lo(v.w); o[7] += b.w * bf_hi(v.w); }
#pragma unroll
    for (int i = 0; i < 8; ++i) o[i] = silu(o[i]);
}
__device__ __forceinline__ int pi32(int m) { const int a = m >> 3, h = (m >> 2) & 1, b = m & 3; return 16 * (a >> 1) + 8 * h + 4 * (a & 1) + b; }
__device__ __forceinline__ int crow(int r, int hi) { return (r & 3) + 8 * (r >> 2) + 4 * hi; }

constexpr int SP = 272;
__device__ __forceinline__ float chunk_scan(const float* dtg, int r0, int valid, int h, float ah, float* acum, float* dtv, int lane) {
    const int s0 = 2 * lane, s1 = 2 * lane + 1;
    const float d0 = (s0 < valid) ? dtg[(size_t)(r0 + s0) * 16 + h] : 0.f, d1 = (s1 < valid) ? dtg[(size_t)(r0 + s1) * 16 + h] : 0.f;
    const float a0 = d0 * ah, a1 = d1 * ah, c = a0 + a1; float incl = c;
#pragma unroll
    for (int o = 1; o < 64; o <<= 1) { const float t = __shfl_up(incl, o); if (lane >= o) incl += t; }
    const float excl = incl - c;
    acum[s0] = excl + a0; acum[s1] = incl; dtv[s0] = d0; dtv[s1] = d1;
    return __shfl(incl, 63);
}

__device__ __forceinline__ void phase_ssd_states(const Params& P, unsigned char* lds, int tid, int wave, int lane) {
    const bf16_t* xbc = (const bf16_t*)(P.ws + WS_XBC); const float* dtg = (const float*)(P.ws + WS_DT);
    bf16_t* st = (bf16_t*)(P.ws + WS_ST); float* cdec = (float*)(P.ws + WS_CDEC); bf16_t* bconv = (bf16_t*)(P.ws + WS_BCONV); bf16_t* mixx = (bf16_t*)(P.ws + WS_MIX);
    unsigned char* Bt = lds;
    unsigned char* XT = lds + 128 * SP + wave * (32 * SP);
    float* acum = (float*)(lds + 128 * SP + 8 * 32 * SP) + wave * 256; float* wts = acum + 128;
    const int r32 = lane & 31, hi = lane >> 5;
    for (int item = blockIdx.x; item < NCH * 2; item += gridDim.x) {
        const int c = item >> 1, g = item & 1; const int r0 = (c == 0) ? 0 : NMETA + 128 * (c - 1), valid = (c == 0) ? NMETA : 128;
        __syncthreads();
        {
            const int n8 = (tid & 15) * 8, s0 = (tid >> 4) * 4, chB = 1024 + g * 128 + n8;
            if (s0 < valid) {
                ConvW W; convw_load(W, P.conv_w, P.conv_b, chB); u32x4 u[7]; conv_rows_load<4>(xbc, r0 + s0, chB, u);
#pragma unroll
                for (int rp = 0; rp < 2; ++rp) { float oa[8], ob[8]; conv_row_out<4>(W, u, 2 * rp, oa); conv_row_out<4>(W, u, 2 * rp + 1, ob);
                    const int sa = s0 + 2 * rp;
                    { u32x4 w; w.x = pk2(oa[0], oa[1]); w.y = pk2(oa[2], oa[3]); w.z = pk2(oa[4], oa[5]); w.w = pk2(oa[6], oa[7]); *(u32x4*)(bconv + (size_t)(r0 + sa) * 256 + g * 128 + n8) = w; }
                    { u32x4 w; w.x = pk2(ob[0], ob[1]); w.y = pk2(ob[2], ob[3]); w.z = pk2(ob[4], ob[5]); w.w = pk2(ob[6], ob[7]); *(u32x4*)(bconv + (size_t)(r0 + sa + 1) * 256 + g * 128 + n8) = w; }
#pragma unroll
                    for (int i = 0; i < 8; ++i) *(unsigned*)(Bt + (n8 + i) * SP + sa * 2) = pk2(oa[i], ob[i]); }
            } else {
#pragma unroll
                for (int rp = 0; rp < 2; ++rp)
#pragma unroll
                    for (int i = 0; i < 8; ++i) *(unsigned*)(Bt + (n8 + i) * SP + (s0 + 2 * rp) * 2) = 0u; }
        }
        const int h = g * 8 + wave; const float ah = -__expf(P.a_log[h]);
        const float total = chunk_scan(dtg, r0, valid, h, ah, acum, wts + 0, lane);
        { const int s0 = 2 * lane; const float w0 = __expf(total - acum[s0]) * wts[s0], w1 = __expf(total - acum[s0 + 1]) * wts[s0 + 1]; wts[s0] = w0; wts[s0 + 1] = w1; }
        if (lane == 0) cdec[c * 16 + h] = __expf(total);
        __syncthreads();
        for (int ph = 0; ph < 2; ++ph) {
            {
                const int p8 = (lane & 3) * 8, s0 = (lane >> 2) * 8, chX = h * 64 + ph * 32 + p8;
                if (s0 < valid) {
                    ConvW W; convw_load(W, P.conv_w, P.conv_b, chX); u32x4 u[11]; conv_rows_load<8>(xbc, r0 + s0, chX, u);
#pragma unroll
                    for (int rp = 0; rp < 4; ++rp) { float oa[8], ob[8]; conv_row_out<8>(W, u, 2 * rp, oa); conv_row_out<8>(W, u, 2 * rp + 1, ob);
                        const int sa = s0 + 2 * rp; const float wa = wts[sa], wb2 = wts[sa + 1];
                        { u32x4 wv; wv.x = pk2(oa[0], oa[1]); wv.y = pk2(oa[2], oa[3]); wv.z = pk2(oa[4], oa[5]); wv.w = pk2(oa[6], oa[7]); *(u32x4*)(mixx + (size_t)(r0 + sa) * 2048 + 1024 + chX) = wv; }
                        { u32x4 wv; wv.x = pk2(ob[0], ob[1]); wv.y = pk2(ob[2], ob[3]); wv.z = pk2(ob[4], ob[5]); wv.w = pk2(ob[6], ob[7]); *(u32x4*)(mixx + (size_t)(r0 + sa + 1) * 2048 + 1024 + chX) = wv; }
#pragma unroll
                        for (int i = 0; i < 8; ++i) *(unsigned*)(XT + (p8 + i) * SP + sa * 2) = pk2(oa[i] * wa, ob[i] * wb2); }
                } else {
#pragma unroll
                    for (int rp = 0; rp < 4; ++rp)
#pragma unroll
                        for (int i = 0; i < 8; ++i) *(unsigned*)(XT + (p8 + i) * SP + (s0 + 2 * rp) * 2) = 0u; }
            }
            __builtin_amdgcn_s_waitcnt(0); asm volatile("" ::: "memory");
            f32x16 acc[4];
#pragma unroll
            for (int nb = 0; nb < 4; ++nb) acc[nb] = f32x16{};
            const int nks = (valid + 15) >> 4;
            for (int ks = 0; ks < nks; ++ks) { const bf16x8 xf = *(const bf16x8*)(XT + r32 * SP + (16 * ks + 8 * hi) * 2);
#pragma unroll
                for (int nb = 0; nb < 4; ++nb) { const bf16x8 bfr = *(const bf16x8*)(Bt + (32 * nb + r32) * SP + (16 * ks + 8 * hi) * 2);
                    acc[nb] = __builtin_amdgcn_mfma_f32_32x32x16_bf16(bfr, xf, acc[nb], 0, 0, 0); } }
#pragma unroll
            for (int nb = 0; nb < 4; ++nb)
#pragma unroll
                for (int rg = 0; rg < 4; ++rg) { u32x2 w; w.x = pk2(acc[nb][4 * rg], acc[nb][4 * rg + 1]); w.y = pk2(acc[nb][4 * rg + 2], acc[nb][4 * rg + 3]);
                    *(u32x2*)(XT + r32 * SP + (32 * nb + 8 * rg + 4 * hi) * 2) = w; }
            __builtin_amdgcn_s_waitcnt(0); asm volatile("" ::: "memory");
            bf16_t* so = st + ((size_t)c * 16 + h) * 8192 + (size_t)(ph * 32) * 128;
#pragma unroll
            for (int it = 0; it < 8; ++it) { const int p = it * 4 + (lane >> 4), ch = lane & 15;
                *(u32x4*)(so + p * 128 + ch * 8) = *(const u32x4*)(XT + p * SP + ch * 16); }
            __builtin_amdgcn_s_waitcnt(0); asm volatile("" ::: "memory");
        }
    }
    __syncthreads();
}

__device__ __forceinline__ void phase_scan(const Params& P, int tid) {
    unsigned* st = (unsigned*)(P.ws + WS_ST); const float* cdec = (const float*)(P.ws + WS_CDEC);
    if (tid < 256) {
        for (int e0 = blockIdx.x * 512; e0 < 131072; e0 += gridDim.x * 512) {
            const int h = __builtin_amdgcn_readfirstlane(e0 >> 13);
            unsigned* pe = st + ((e0 >> 1) + tid);
            float h0 = 0.f, h1 = 0.f;
#pragma nounroll
            for (int seg = 0; seg < 3; ++seg) {
                unsigned v[43]; unsigned* ps = pe + (size_t)(43 * seg) * 65536; const float* dcp = cdec + (43 * seg) * 16 + h;
#pragma unroll
                for (int c = 0; c < 43; ++c) v[c] = ps[(size_t)c * 65536];
#pragma unroll
                for (int c = 0; c < 43; ++c) { const float dc = dcp[c * 16]; ps[(size_t)c * 65536] = pk2(h0, h1); h0 = dc * h0 + bf_lo(v[c]); h1 = dc * h1 + bf_hi(v[c]); }
            }
        }
    }
}

__device__ __forceinline__ void phase_ssd_y(const Params& P, unsigned char* lds, int tid, int wave, int lane) {
    const bf16_t* xbc = (const bf16_t*)(P.ws + WS_XBC); const float* dtg = (const float*)(P.ws + WS_DT); const bf16_t* zb = (const bf16_t*)(P.ws + WS_Z);
    const bf16_t* st = (const bf16_t*)(P.ws + WS_ST); bf16_t* mix = (bf16_t*)(P.ws + WS_MIX); const bf16_t* bconv = (const bf16_t*)(P.ws + WS_BCONV);
    unsigned char* Bs = lds; unsigned char* Cs = lds + 128 * SP;
    unsigned char* XT = lds + 2 * 128 * SP + wave * (32 * SP);
    unsigned char* YS = XT;
    float* acum = (float*)(lds + 2 * 128 * SP + 8 * 32 * SP) + wave * 384; float* dtv = acum + 128; float* gtab = acum + 256;
    float* rowss = (float*)(lds + 2 * 128 * SP + 8 * 32 * SP + 8 * 1536);
    static_assert(2 * 128 * SP + 8 * 32 * SP + 8 * 1536 + 8192 <= LDS_BYTES - 64, "ssd_y LDS");
    const int r32 = lane & 31, hi = lane >> 5;
    for (int item = blockIdx.x; item < NCH * 2; item += gridDim.x) {
        const int c = item >> 1, g = item & 1; const int r0 = (c == 0) ? 0 : NMETA + 128 * (c - 1), valid = (c == 0) ? NMETA : 128;
        if (c == 0) continue;
        __syncthreads();
        for (int ck = tid; ck < 4096; ck += 512) { const int isC = ck >> 11, c2 = ck & 2047, s = c2 >> 4, n8 = (c2 & 15) * 8; float o[8];
            u32x4 w = {0u, 0u, 0u, 0u};
            if (s < valid) { if (isC) { conv8(xbc, P.conv_w, P.conv_b, r0 + s, 1280 + g * 128 + n8, o); w.x = pk2(o[0], o[1]); w.y = pk2(o[2], o[3]); w.z = pk2(o[4], o[5]); w.w = pk2(o[6], o[7]); }
                             else w = *(const u32x4*)(bconv + (size_t)(r0 + s) * 256 + g * 128 + n8); }
            *(u32x4*)((isC ? Cs : Bs) + s * SP + n8 * 2) = w; }
        const int h = g * 8 + wave; const float ah = -__expf(P.a_log[h]); const float dsk = P.d_skip[h];
        (void)chunk_scan(dtg, r0, valid, h, ah, acum, dtv, lane);
        { const int s0 = 2 * lane; const float R = acum[(s0 & ~31) + 31]; gtab[s0] = __expf(R - acum[s0]) * dtv[s0]; gtab[s0 + 1] = __expf(R - acum[s0 + 1]) * dtv[s0 + 1]; }
        __syncthreads();
        for (int ph = 0; ph < 2; ++ph) {
            for (int ck = lane; ck < 512; ck += 64) { const int s = ck >> 2, p8 = (ck & 3) * 8; float o[8];
                u32x4 xv = {0u, 0u, 0u, 0u};
                if (s < valid) xv = *(const u32x4*)(mix + (size_t)(r0 + s) * 2048 + 1024 + h * 64 + ph * 32 + p8);
                (void)o;
#pragma unroll
                for (int i = 0; i < 4; ++i) { *(bf16_t*)(XT + (p8 + 2 * i) * SP + s * 2) = (bf16_t)(xv[i] & 0xffffu); *(bf16_t*)(XT + (p8 + 2 * i + 1) * SP + s * 2) = (bf16_t)(xv[i] >> 16); } }
            bf16x8 pvf[8];
            { const bf16_t* pv = st + ((size_t)c * 16 + h) * 8192 + (size_t)(ph * 32 + r32) * 128 + 8 * hi;
#pragma unroll
              for (int ks = 0; ks < 8; ++ks) pvf[ks] = *(const bf16x8*)(pv + 16 * ks); }
            __builtin_amdgcn_s_waitcnt(0); asm volatile("" ::: "memory");
            const int nlb = (valid + 31) >> 5;
            u32x2 yp[4][4];
#pragma unroll
            for (int q4 = 0; q4 < 4; ++q4)
#pragma unroll
                for (int rg = 0; rg < 4; ++rg) yp[q4][rg] = (u32x2){0u, 0u};
            for (int lb = 0; lb < nlb; ++lb) {
                const int l = 32 * lb + r32;
                bf16x8 cf[8];
#pragma unroll
                for (int ks = 0; ks < 8; ++ks) cf[ks] = *(const bf16x8*)(Cs + l * SP + (16 * ks + 8 * hi) * 2);
                f32x16 accd = f32x16{}, acco = f32x16{};
#pragma unroll
                for (int ks = 0; ks < 8; ++ks) acco = __builtin_amdgcn_mfma_f32_32x32x16_bf16(pvf[ks], cf[ks], acco, 0, 0, 0);
                const float al = acum[l];
                for (int sb = 0; sb <= lb; ++sb) {
                    f32x16 sT = f32x16{};
                    const unsigned char* brow = Bs + (32 * sb + pi32(r32)) * SP + 16 * hi;
                    { bf16x8 bb[2]; bb[0] = *(const bf16x8*)(brow); bb[1] = *(const bf16x8*)(brow + 32);
#pragma unroll
                      for (int ks = 0; ks < 8; ++ks) { sT = __builtin_amdgcn_mfma_f32_32x32x16_bf16(bb[ks & 1], cf[ks], sT, 0, 0, 0); if (ks + 2 < 8) bb[ks & 1] = *(const bf16x8*)(brow + 32 * (ks + 2)); } }
                    unsigned wb[8];
                    if (sb < lb) {
                        const float fl = __expf(al - acum[32 * sb + 31]);
#pragma unroll
                        for (int hf = 0; hf < 2; ++hf) {
                            const int sb0 = 32 * sb + 16 * hf + 8 * hi;
                            const f32x4 d0 = *(const f32x4*)(gtab + sb0), d1 = *(const f32x4*)(gtab + sb0 + 4);
#pragma unroll
                            for (int j = 0; j < 4; ++j) { const float ga = (j < 2) ? d0[2 * j] : d1[2 * j - 4], gb = (j < 2) ? d0[2 * j + 1] : d1[2 * j - 3];
                                wb[4 * hf + j] = pk2(sT[8 * hf + 2 * j] * (fl * ga), sT[8 * hf + 2 * j + 1] * (fl * gb)); } }
                    } else {
#pragma unroll
                        for (int hf = 0; hf < 2; ++hf) {
                            const int sb0 = 32 * sb + 16 * hf + 8 * hi;
                            const f32x4 a0 = *(const f32x4*)(acum + sb0), a1 = *(const f32x4*)(acum + sb0 + 4), d0 = *(const f32x4*)(dtv + sb0), d1 = *(const f32x4*)(dtv + sb0 + 4);
                            float wv[8];
#pragma unroll
                            for (int j = 0; j < 8; ++j) { const float aj = (j < 4) ? a0[j & 3] : a1[j & 3], dj = (j < 4) ? d0[j & 3] : d1[j & 3]; const int sj = sb0 + j;
                                const float e = __expf(fminf(al - aj, 0.f)) * dj; float v = sT[8 * hf + j] * e; v = (sj <= l) ? v : 0.f; v += (sj == l) ? dsk : 0.f; wv[j] = v; }
#pragma unroll
                            for (int j = 0; j < 4; ++j) wb[4 * hf + j] = pk2(wv[2 * j], wv[2 * j + 1]); } }
                    const u32x4 w0 = {wb[0], wb[1], wb[2], wb[3]}, w1 = {wb[4], wb[5], wb[6], wb[7]};
                    const bf16x8 x0 = *(const bf16x8*)(XT + r32 * SP + (32 * sb + 8 * hi) * 2), x1 = *(const bf16x8*)(XT + r32 * SP + (32 * sb + 16 + 8 * hi) * 2);
                    accd = __builtin_amdgcn_mfma_f32_32x32x16_bf16(x0, __builtin_bit_cast(bf16x8, w0), accd, 0, 0, 0);
                    accd = __builtin_amdgcn_mfma_f32_32x32x16_bf16(x1, __builtin_bit_cast(bf16x8, w1), accd, 0, 0, 0);
                }
                { const float el = __expf(al);
#pragma unroll
                  for (int rg = 0; rg < 4; ++rg) { u32x2 w; w.x = pk2(accd[4 * rg] + el * acco[4 * rg], accd[4 * rg + 1] + el * acco[4 * rg + 1]); w.y = pk2(accd[4 * rg + 2] + el * acco[4 * rg + 2], accd[4 * rg + 3] + el * acco[4 * rg + 3]);
#pragma unroll
                      for (int q4 = 0; q4 < 4; ++q4) if (q4 == lb) yp[q4][rg] = w; } }
            }
#pragma unroll
            for (int q4 = 0; q4 < 4; ++q4) if (q4 < nlb) {
#pragma unroll
                for (int rg = 0; rg < 4; ++rg) *(u32x2*)(YS + (32 * q4 + r32) * 64 + (8 * rg + 4 * hi) * 2) = yp[q4][rg]; }
            __builtin_amdgcn_s_waitcnt(0); asm volatile("" ::: "memory");
            for (int it = 0; it < 2 * nlb; ++it) { const int l = it * 16 + (lane >> 2), c8 = (lane & 3) * 8; const size_t row = (size_t)(r0 + l);
                const u32x4 yb = *(const u32x4*)(YS + l * 64 + c8 * 2); u32x4 zz = {0u, 0u, 0u, 0u};
                if (l < valid) zz = *(const u32x4*)(zb + row * 1024 + h * 64 + ph * 32 + c8);
                float gq[8]; float ss = 0.f;
#pragma unroll
                for (int j = 0; j < 4; ++j) { gq[2 * j] = bf_lo(yb[j]) * silu(bf_lo(zz[j])); gq[2 * j + 1] = bf_hi(yb[j]) * silu(bf_hi(zz[j])); ss += gq[2 * j] * gq[2 * j] + gq[2 * j + 1] * gq[2 * j + 1]; }
                ss += __shfl_xor(ss, 1); ss += __shfl_xor(ss, 2);
                if ((lane & 3) == 0) rowss[(wave * 2 + ph) * 128 + l] = ss;
                if (l < valid) { u32x4 w; w.x = pk2(gq[0], gq[1]); w.y = pk2(gq[2], gq[3]); w.z = pk2(gq[4], gq[5]); w.w = pk2(gq[6], gq[7]); *(u32x4*)(mix + row * 2048 + 1024 + h * 64 + ph * 32 + c8) = w; } }
            __builtin_amdgcn_s_waitcnt(0); asm volatile("" ::: "memory");
        }
        __syncthreads();
        { const int l = tid >> 2, qd = tid & 3;
          if (l < valid) { float ss = 0.f;
#pragma unroll
              for (int k = 0; k < 16; ++k) ss += rowss[k * 128 + l];
              const float rstd = rsqrtf(ss * (1.f / 512.f) + EPS);
              bf16_t* rp = mix + (size_t)(r0 + l) * 2048 + 1024 + g * 512 + qd * 128; const float* gp = P.g_ssm + g * 512 + qd * 128;
#pragma unroll 4
              for (int k = 0; k < 16; ++k) { const u32x4 u = *(const u32x4*)(rp + 8 * k); const f32x4 g0 = *(const f32x4*)(gp + 8 * k), g1 = *(const f32x4*)(gp + 8 * k + 4);
                  u32x4 w; w.x = pk2(bf_lo(u.x) * rstd * g0.x, bf_hi(u.x) * rstd * g0.y); w.y = pk2(bf_lo(u.y) * rstd * g0.z, bf_hi(u.y) * rstd * g0.w);
                  w.z = pk2(bf_lo(u.z) * rstd * g1.x, bf_hi(u.z) * rstd * g1.y); w.w = pk2(bf_lo(u.w) * rstd * g1.z, bf_hi(u.w) * rstd * g1.w);
                  *(u32x4*)(rp + 8 * k) = w; } } }
    }
    __syncthreads();
}

namespace att {
constexpr int KP = 400, VP = 144, KT_BYTES = 64 * KP, VT_BYTES = 128 * VP, STG = KT_BYTES + VT_BYTES;
struct Stage { u32x4 k0, k1, kr, v0, v1; };
__device__ __forceinline__ void gload(Stage& s, const bf16_t* kb, const bf16_t* krb, const bf16_t* vt, int h, int kbase, int tid) {
    s.k0 = *(const u32x4*)(kb + (size_t)(kbase + (tid >> 4)) * 1024 + h * 128 + (tid & 15) * 8);
    s.k1 = *(const u32x4*)(kb + (size_t)(kbase + 32 + (tid >> 4)) * 1024 + h * 128 + (tid & 15) * 8);
    s.kr = *(const u32x4*)(krb + (size_t)(kbase + (tid >> 3)) * 64 + (tid & 7) * 8);
    s.v0 = *(const u32x4*)(vt + (size_t)(h * 128 + (tid >> 3)) * MP + kbase + (tid & 7) * 8);
    s.v1 = *(const u32x4*)(vt + (size_t)(h * 128 + 64 + (tid >> 3)) * MP + kbase + (tid & 7) * 8);
}
__device__ __forceinline__ void sstore(const Stage& s, unsigned char* buf, int tid) {
    unsigned char* Kt = buf; unsigned char* Vt = buf + KT_BYTES;
    *(u32x4*)(Kt + (tid >> 4) * KP + (tid & 15) * 16) = s.k0;
    *(u32x4*)(Kt + (32 + (tid >> 4)) * KP + (tid & 15) * 16) = s.k1;
    *(u32x4*)(Kt + (tid >> 3) * KP + 256 + (tid & 7) * 16) = s.kr;
    *(u32x4*)(Vt + (tid >> 3) * VP + (tid & 7) * 16) = s.v0;
    *(u32x4*)(Vt + (64 + (tid >> 3)) * VP + (tid & 7) * 16) = s.v1;
}
constexpr int VSLOT0 = 2 * KT_BYTES;
__device__ __forceinline__ void glds16(const void* gsrc, unsigned lds_dst) { unsigned keep;
    asm volatile("s_mov_b32 %0, m0\n\ts_mov_b32 m0, %2\n\ts_nop 0\n\tglobal_load_lds_dwordx4 %1, off\n\ts_mov_b32 m0, %0" : "=&s"(keep) : "v"(gsrc), "s"(lds_dst) : "memory"); }
constexpr float THR = 8.f;
__device__ __forceinline__ float max3f(float a, float b, float c) { float r; asm("v_max3_f32 %0, %1, %2, %3" : "=v"(r) : "v"(a), "v"(b), "v"(c)); return r; }
__device__ __forceinline__ float max2f(float a, float b) { float r; asm("v_max_f32_e32 %0, %1, %2" : "=v"(r) : "v"(a), "v"(b)); return r; }
__device__ __forceinline__ float xhalf_max(float m) { auto rr = __builtin_amdgcn_permlane32_swap(__float_as_uint(m), __float_as_uint(m), false, false); return max2f(__uint_as_float(rr[0]), __uint_as_float(rr[1])); }
#define ATT_SB() __builtin_amdgcn_sched_barrier(0)
__device__ __forceinline__ void unit(const Params& P, unsigned char* lds, int h, int q0, int NT, int slo, int shi, int tid, int wave, int lane) {
    const bf16_t* qb = (const bf16_t*)(P.ws + WS_Q); const bf16_t* kb = (const bf16_t*)(P.ws + WS_K); const bf16_t* krb = (const bf16_t*)(P.ws + WS_KR);
    const bf16_t* vt = (const bf16_t*)(P.ws + WS_VT); bf16_t* mix = (bf16_t*)(P.ws + WS_MIX); const float2* rope = (const float2*)(P.ws + WS_ROPE);
    const int r32 = lane & 31, hi = lane >> 5;
    const int qrow = q0 + 32 * wave + r32;
    const unsigned lds0 = (unsigned)(uintptr_t)lds;
    unsigned koff[4], voff[3];
#pragma unroll
    for (int j = 0; j < 4; ++j) { const int i = 64 * (wave + 8 * j) + lane, row = i / 25, col = i - 25 * row;
        if (col >= 16 && col < 24) koff[j] = ((unsigned)WS_KR + (unsigned)((row * 64 + (col - 16) * 8) * 2)) | 1u;
        else koff[j] = (unsigned)WS_K + (unsigned)((row * 1024 + h * 128 + (col < 16 ? col : 0) * 8) * 2); }
#pragma unroll
    for (int j = 0; j < 3; ++j) { const int i = 64 * (wave + 8 * j) + lane, d = i / 9, c = i - 9 * d; voff[j] = (unsigned)WS_VT + (unsigned)(((h * 128 + d) * MP + (c < 8 ? c : 0) * 8) * 2); }
#define ATT_ISSUE(t, kslot, vslot) do { const unsigned t_ = (unsigned)(t); \
        _Pragma("unroll") for (int j = 0; j < 4; ++j) if (wave + 8 * j < 25) glds16(P.ws + ((koff[j] & ~1u) + t_ * ((koff[j] & 1u) ? 64u * 128u : 64u * 2048u)), (unsigned)__builtin_amdgcn_readfirstlane(lds0 + (kslot) * KT_BYTES + (wave + 8 * j) * 1024)); \
        _Pragma("unroll") for (int j = 0; j < 3; ++j) if (wave + 8 * j < 18) glds16(P.ws + (voff[j] + t_ * 128u), (unsigned)__builtin_amdgcn_readfirstlane(lds0 + VSLOT0 + (vslot) * VT_BYTES + (wave + 8 * j) * 1024)); } while (0)
#define ATT_ISSUE1(slot, t, kslot, vslot) do { const unsigned t_ = (unsigned)(t); \
        if ((slot) < 4) { if (wave + 8 * (slot) < 25) glds16(P.ws + ((koff[(slot) & 3] & ~1u) + t_ * ((koff[(slot) & 3] & 1u) ? 64u * 128u : 64u * 2048u)), (unsigned)__builtin_amdgcn_readfirstlane(lds0 + (kslot) * KT_BYTES + (wave + 8 * (slot)) * 1024)); } \
        else { if (wave + 8 * ((slot) - 4) < 18) glds16(P.ws + (voff[((slot) - 4) % 3] + t_ * 128u), (unsigned)__builtin_amdgcn_readfirstlane(lds0 + VSLOT0 + (vslot) * VT_BYTES + (wave + 8 * ((slot) - 4)) * 1024)); } } while (0)
    ATT_ISSUE(0, 0, 0);
    bf16x8 qf[12];
    { const bf16_t* qp = qb + (size_t)qrow * QW + h * 192 + 8 * hi;
#pragma unroll
      for (int ks = 0; ks < 12; ++ks) qf[ks] = *(const bf16x8*)(qp + 16 * ks);
#pragma unroll
      for (int kk = 0; kk < 2; ++kk) { u32x4 a = __builtin_bit_cast(u32x4, qf[8 + kk]), b = __builtin_bit_cast(u32x4, qf[10 + kk]); u32x4 oa, ob;
          const float2* cs = rope + (size_t)qrow * 32 + 16 * kk + 8 * hi;
#pragma unroll
          for (int j = 0; j < 4; ++j) { const float2 c0 = cs[2 * j], c1 = cs[2 * j + 1];
              const float x1a = bf_lo(a[j]), x1b = bf_hi(a[j]), x2a = bf_lo(b[j]), x2b = bf_hi(b[j]);
              oa[j] = pk2(x1a * c0.x - x2a * c0.y, x1b * c1.x - x2b * c1.y); ob[j] = pk2(x2a * c0.x + x1a * c0.y, x2b * c1.x + x1b * c1.y); }
          qf[8 + kk] = __builtin_bit_cast(bf16x8, oa); qf[10 + kk] = __builtin_bit_cast(bf16x8, ob); } }
    f32x16 o[4];
#pragma unroll
    for (int d = 0; d < 4; ++d) o[d] = f32x16{};
    float mref = 0.f, lsum = 0.f;
    asm volatile("s_waitcnt vmcnt(0)" ::: "memory");
    __syncthreads();
    const int qmin_w = q0 + 32 * wave, qmax_w = qmin_w + 31;
    const int krow_off = pi32(r32) * KP + 16 * hi;
    f32x16 sA = f32x16{}, sB = f32x16{};
    u32x4 onesf = {hi == 0 ? 0x00003F80u : 0u, 0u, 0u, 0u}, mshf = {0u, 0u, 0u, 0u};
    auto bfround = [](float v) { return __uint_as_float(pk2(v, 0.f) << 16); };
    u32x4 pw0 = {0u, 0u, 0u, 0u}, pw1 = {0u, 0u, 0u, 0u};
#define ATT_FIN4(PC, B) do { lsum += (PC[B] + PC[B + 1]) + (PC[B + 2] + PC[B + 3]); } while (0)
#define ATT_PV(HP) do { const unsigned char* Vh = lds + VSLOT0 + ((((HP) >> 1) % 3) * VT_BYTES) + r32 * VP + (32 * ((HP) & 1) + 8 * hi) * 2; \
        _Pragma("unroll") for (int d = 0; d < 4; ++d) { const bf16x8 v0 = *(const bf16x8*)(Vh + 32 * d * VP), v1 = *(const bf16x8*)(Vh + 32 * d * VP + 32); \
            o[d] = __builtin_amdgcn_mfma_f32_32x32x16_bf16(v0, __builtin_bit_cast(bf16x8, pw0), o[d], 0, 0, 0); o[d] = __builtin_amdgcn_mfma_f32_32x32x16_bf16(v1, __builtin_bit_cast(bf16x8, pw1), o[d], 0, 0, 0); } } while (0)
#define ATT_QKCHAIN(SN, kp_, DMAON, tn_, ksl_, vsl_) do { \
        { const f32x16 z16_ = {0.f, 0.f, 0.f, 0.f, 0.f, 0.f, 0.f, 0.f, 0.f, 0.f, 0.f, 0.f, 0.f, 0.f, 0.f, 0.f}; SN = z16_; } \
        bf16x8 ka_[2]; ka_[0] = *(const bf16x8*)(kp_); ka_[1] = *(const bf16x8*)(kp_ + 32); \
        _Pragma("unroll") for (int ks = 0; ks < 12; ++ks) { \
            SN = __builtin_amdgcn_mfma_f32_32x32x16_bf16(ka_[ks & 1], qf[ks], SN, 0, 0, 0); \
            if (ks + 2 < 12) ka_[ks & 1] = *(const bf16x8*)(kp_ + 32 * (ks + 2)); \
            if ((DMAON) == 1) { if (ks == 2) ATT_ISSUE1(0, tn_, ksl_, vsl_); else if (ks == 5) ATT_ISSUE1(1, tn_, ksl_, vsl_); else if (ks == 8) ATT_ISSUE1(2, tn_, ksl_, vsl_); else if (ks == 11) ATT_ISSUE1(3, tn_, ksl_, vsl_); } \
            else if ((DMAON) == 2) { if (ks == 2) ATT_ISSUE1(4, tn_, ksl_, vsl_); else if (ks == 5) ATT_ISSUE1(5, tn_, ksl_, vsl_); else if (ks == 8) ATT_ISSUE1(6, tn_, ksl_, vsl_); } } } while (0)
#define ATT_ROWSUM(PC) do { float la_ = 0.f; \
        asm("v_add_f32_e32 %0, %0, %2\n\tv_add_f32_e32 %1, %1, %3\n\tv_add_f32_e32 %0, %0, %4\n\tv_add_f32_e32 %1, %1, %5\n\t" \
            "v_add_f32_e32 %0, %0, %6\n\tv_add_f32_e32 %1, %1, %7\n\tv_add_f32_e32 %0, %0, %8\n\tv_add_f32_e32 %1, %1, %9\n\t" \
            "v_add_f32_e32 %0, %0, %10\n\tv_add_f32_e32 %1, %1, %11\n\tv_add_f32_e32 %0, %0, %12\n\tv_add_f32_e32 %1, %1, %13\n\t" \
            "v_add_f32_e32 %0, %0, %14\n\tv_add_f32_e32 %1, %1, %15\n\tv_add_f32_e32 %0, %0, %16\n\tv_add_f32_e32 %1, %1, %17\n\t" \
            "v_add_f32_e32 %0, %0, %1" \
            : "+v"(lsum), "+v"(la_) : "v"(PC[0]), "v"(PC[1]), "v"(PC[2]), "v"(PC[3]), "v"(PC[4]), "v"(PC[5]), "v"(PC[6]), "v"(PC[7]), \
              "v"(PC[8]), "v"(PC[9]), "v"(PC[10]), "v"(PC[11]), "v"(PC[12]), "v"(PC[13]), "v"(PC[14]), "v"(PC[15])); } while (0)
#define ATT_EXPPACK(PC) do { \
        _Pragma("unroll") for (int r = 0; r < 16; ++r) PC[r] = __builtin_amdgcn_exp2f(PC[r]); \
        ATT_SB();     \
        ATT_ROWSUM(PC); \
        pw0.x = pk2(PC[0], PC[1]); pw0.y = pk2(PC[2], PC[3]); pw0.z = pk2(PC[4], PC[5]); pw0.w = pk2(PC[6], PC[7]); \
        pw1.x = pk2(PC[8], PC[9]); pw1.y = pk2(PC[10], PC[11]); pw1.z = pk2(PC[12], PC[13]); pw1.w = pk2(PC[14], PC[15]); } while (0)
#define ATT_STEP(SN, PC, hh, KtP, FIRST, DMAON, tn_, ksl_, vsl_) do { \
        { \
            const unsigned char* kp_ = (KtP) + 32 * ((hh) & 1) * KP + krow_off; \
              \
            ATT_QKCHAIN(SN, kp_, DMAON, tn_, ksl_, vsl_); \
            if (!(FIRST)) { ATT_EXPPACK(PC); } \
            if (!(FIRST)) SN = __builtin_amdgcn_mfma_f32_32x32x16_bf16(__builtin_bit_cast(bf16x8, onesf), __builtin_bit_cast(bf16x8, mshf), SN, 0, 0, 0);     \
              \
            if (32 * (hh) + 31 > qmin_w) { const int kq_ = qrow - 32 * (hh) - 8 * hi; \
                _Pragma("unroll") for (int r = 0; r < 16; ++r) SN[r] = ((16 * (r >> 3) + (r & 7)) > kq_) ? -1e30f : SN[r]; } \
            float mx_; \
            if (!(FIRST)) { \
                const unsigned char* Vh = lds + VSLOT0 + (((((hh) - 1) >> 1) % 3) * VT_BYTES) + r32 * VP + (32 * (((hh) - 1) & 1) + 8 * hi) * 2; \
                bf16x8 va_[2]; va_[0] = *(const bf16x8*)(Vh); va_[1] = *(const bf16x8*)(Vh + 32); \
                _Pragma("unroll") for (int i = 0; i < 8; ++i) { \
                    o[i >> 1] = __builtin_amdgcn_mfma_f32_32x32x16_bf16(va_[i & 1], __builtin_bit_cast(bf16x8, (i & 1) ? pw1 : pw0), o[i >> 1], 0, 0, 0); \
                    ATT_SB(); \
                    if (i + 2 < 8) va_[i & 1] = *(const bf16x8*)(Vh + 32 * ((i + 2) >> 1) * VP + 32 * ((i + 2) & 1)); \
                    if (i == 0) mx_ = __builtin_fmaxf(SN[0], __builtin_fmaxf(SN[1], SN[2]));   \
                    else if (i < 7) mx_ = max3f(mx_, SN[2 * i + 1], SN[2 * i + 2]); else mx_ = max2f(mx_, SN[15]); \
                    ATT_SB(); } \
            } else { \
                mx_ = __builtin_fmaxf(SN[0], __builtin_fmaxf(SN[1], SN[2])); \
                _Pragma("unroll") for (int i = 1; i < 7; ++i) mx_ = max3f(mx_, SN[2 * i + 1], SN[2 * i + 2]); \
                mx_ = max2f(mx_, SN[15]); } \
            mx_ = xhalf_max(mx_); \
            if (FIRST) { mref = bfround(mx_); mshf.x = (hi == 0) ? (pk2(-mref, 0.f) & 0xffffu) : 0u; _Pragma("unroll") for (int r = 0; r < 16; ++r) SN[r] -= mref; } \
            else if (__any(mx_ > THR)) { const float mn_ = bfround(mref + fmaxf(mx_, 0.f)); const float dl_ = mn_ - mref; mref = mn_; mshf.x = (hi == 0) ? (pk2(-mref, 0.f) & 0xffffu) : 0u; \
                const float f_ = __builtin_amdgcn_exp2f(-dl_); lsum *= f_; \
                _Pragma("unroll") for (int r = 0; r < 16; ++r) SN[r] -= dl_; \
                _Pragma("unroll") for (int d = 0; d < 4; ++d) o[d] = o[d] * f_; } \
            ATT_SB(); \
        } \
    } while (0)
    {
        const bool more0 = 1 < NT;
        ATT_STEP(sA, sB, 0, lds, 1, (more0 ? 1 : 0), 1, 1, 1);
        ATT_STEP(sB, sA, 1, lds, 0, (more0 ? 2 : 0), 1, 1, 1);
        asm volatile("s_waitcnt vmcnt(0)" ::: "memory");
        __syncthreads();
    }
    for (int kt = 1; kt < NT; ++kt) {
        const bool more = kt + 1 < NT; const int ksn = (kt + 1) & 1, vsn = (kt + 1) % 3;
        const unsigned char* Kt = lds + (kt & 1) * KT_BYTES;
        ATT_STEP(sA, sB, 2 * kt, Kt, 0, (more ? 1 : 0), kt + 1, ksn, vsn);
        ATT_STEP(sB, sA, 2 * kt + 1, Kt, 0, (more ? 2 : 0), kt + 1, ksn, vsn);
        asm volatile("s_waitcnt vmcnt(0)" ::: "memory");
        __syncthreads();
    }
    {
#pragma unroll
        for (int r = 0; r < 16; ++r) sB[r] = __builtin_amdgcn_exp2f(sB[r]);
        pw0.x = pk2(sB[0], sB[1]); pw0.y = pk2(sB[2], sB[3]); pw0.z = pk2(sB[4], sB[5]); pw0.w = pk2(sB[6], sB[7]);
        pw1.x = pk2(sB[8], sB[9]); pw1.y = pk2(sB[10], sB[11]); pw1.z = pk2(sB[12], sB[13]); pw1.w = pk2(sB[14], sB[15]);
        ATT_SB();
        ATT_ROWSUM(sB);
        ATT_PV(2 * NT - 1);
        __syncthreads();
    }
#undef ATT_ISSUE
#undef ATT_ISSUE1
#undef ATT_STEP
#undef ATT_QKCHAIN
#undef ATT_EXPPACK
#undef ATT_ROWSUM
#undef ATT_PV
#undef ATT_FIN4
    lsum += __shfl_xor(lsum, 32);
    const float inv = 1.f / lsum;
    if (qrow >= slo && qrow < shi) {
        bf16_t* op = mix + (size_t)qrow * 2048 + h * 128 + 4 * hi;
#pragma unroll
        for (int d = 0; d < 4; ++d)
#pragma unroll
            for (int rg = 0; rg < 4; ++rg) { u32x2 w; w.x = pk2(o[d][4 * rg] * inv, o[d][4 * rg + 1] * inv); w.y = pk2(o[d][4 * rg + 2] * inv, o[d][4 * rg + 3] * inv);
                *(u32x2*)(op + 32 * d + 8 * rg) = w; }
    }
}
__device__ __forceinline__ void phase(const Params& P, unsigned char* lds, int tid, int wave, int lane) {
    for (int w = blockIdx.x; w < 256; w += gridDim.x) {
        const int nu = (w < 256) ? 2 : 1;
#pragma nounroll
        for (int u = 0; u < nu; ++u) {
            int h, b; if (w < 256) { h = w & 7; const int j = w >> 3; b = (u == 0) ? 64 - j : j + 1; } else { h = w - 256; b = 0; }
            const int q0 = b ? NMETA + 256 * (b - 1) : 0, NT = b ? 4 * b + 1 : 1, shi = b ? q0 + 256 : NMETA;
            unit(P, lds, h, q0, NT, q0, shi, tid, wave, lane);
        }
    }
}
}

__device__ __forceinline__ void phase_rows1(const Params& P, int gw, int NGW, int lane) {
    const bf16_t* mixo = (const bf16_t*)(P.ws + WS_MIXO); bf16_t* hn2 = (bf16_t*)(P.ws + WS_HN2);
    for (int m = gw; m < SEQ; m += NGW) {
        const u32x2* mr = (const u32x2*)(mixo + (size_t)m * DM) + lane; const f32x4* xr = (const f32x4*)(P.x + (size_t)m * DM) + lane;
        const f32x4* g1 = (const f32x4*)P.g_mix_post + lane; const f32x4* g2 = (const f32x4*)P.g_mlp_pre + lane;
        f32x4 v[4]; float s = 0.f;
#pragma unroll
        for (int j = 0; j < 4; ++j) { const u32x2 u = mr[64 * j]; v[j] = (f32x4){bf_lo(u.x), bf_hi(u.x), bf_lo(u.y), bf_hi(u.y)}; s += (v[j].x * v[j].x + v[j].y * v[j].y) + (v[j].z * v[j].z + v[j].w * v[j].w); }
        const float r1 = rsqrtf(wave_sum(s) * (1.f / DM) + EPS); float s2 = 0.f;
#pragma unroll
        for (int j = 0; j < 4; ++j) { v[j] = xr[64 * j] + v[j] * r1 * g1[64 * j]; s2 += (v[j].x * v[j].x + v[j].y * v[j].y) + (v[j].z * v[j].z + v[j].w * v[j].w); }
        const float r2 = rsqrtf(wave_sum(s2) * (1.f / DM) + EPS);
        f32x4* orow = (f32x4*)(P.out + (size_t)m * DM) + lane; unsigned long long* o8 = (unsigned long long*)(hn2 + (size_t)m * DM) + lane;
#pragma unroll
        for (int j = 0; j < 4; ++j) { orow[64 * j] = v[j]; const f32x4 g = g2[64 * j];
            o8[64 * j] = (unsigned long long)pk2(v[j].x * r2 * g.x, v[j].y * r2 * g.y) | ((unsigned long long)pk2(v[j].z * r2 * g.z, v[j].w * r2 * g.w) << 32); }
    }
}
__device__ __forceinline__ void phase_rows2(const Params& P, int gw, int NGW, int lane) {
    const bf16_t* f = (const bf16_t*)(P.ws + WS_F);
    for (int m = gw; m < SEQ; m += NGW) {
        const u32x2* fr = (const u32x2*)(f + (size_t)m * DM) + lane; f32x4* orow = (f32x4*)(P.out + (size_t)m * DM) + lane; const f32x4* g1 = (const f32x4*)P.g_mlp_post + lane;
        f32x4 v[4]; float s = 0.f;
#pragma unroll
        for (int j = 0; j < 4; ++j) { const u32x2 u = fr[64 * j]; v[j] = (f32x4){bf_lo(u.x), bf_hi(u.x), bf_lo(u.y), bf_hi(u.y)}; s += (v[j].x * v[j].x + v[j].y * v[j].y) + (v[j].z * v[j].z + v[j].w * v[j].w); }
        const float r1 = rsqrtf(wave_sum(s) * (1.f / DM) + EPS);
#pragma unroll
        for (int j = 0; j < 4; ++j) orow[64 * j] = orow[64 * j] + v[j] * r1 * g1[64 * j];
    }
}

#define LAS __attribute__((address_space(3)))
#define XB_TMO      128
#define XB_XCNT(j)  (256  + 64 * (j))
#define XB_XSUB(j)  (1280 + 64 * (j))
#define XB_XGEN(j)  (2304 + 64 * (j))
#define XB_TOP      3328
#define XB_TOPGEN   3392
#define XCD_BAR_WORDS 3456
#define XB_SPIN_CAP (1u << 18)
__device__ __forceinline__ unsigned xb_ld(unsigned* p)              { return __hip_atomic_load(p, __ATOMIC_RELAXED, __HIP_MEMORY_SCOPE_AGENT); }
__device__ __forceinline__ unsigned xb_add(unsigned* p, unsigned v) { return __hip_atomic_fetch_add(p, v, __ATOMIC_RELAXED, __HIP_MEMORY_SCOPE_AGENT); }
__device__ __forceinline__ unsigned xb_xcc_id() { return (unsigned)__builtin_amdgcn_s_getreg((3 << 11) | 20) & 0xFu; }
#define XB_SPIN(cond, bar) do { unsigned _sp = 0; while (cond) { __builtin_amdgcn_s_sleep(1); \
    if ((++_sp & 255u) == 0u) { if (xb_ld(&(bar)[XB_TMO])) break; if (_sp > XB_SPIN_CAP) { atomicAdd(&(bar)[XB_TMO], 1u); break; } } } } while (0)
struct XcdBarrier { unsigned* bar; unsigned x; volatile LAS unsigned* st; };
__device__ __forceinline__ XcdBarrier xcd_barrier_post(unsigned* bar, volatile LAS unsigned* st) {
    XcdBarrier b; b.bar = bar; b.x = xb_xcc_id(); b.st = st;
    if (threadIdx.x == 0) (void)xb_add(&bar[XB_XCNT(b.x)], 1u);
    return b;
}
__device__ __forceinline__ void xcd_barrier_complete(unsigned* bar, unsigned x, unsigned& nloc, unsigned& nx) {
    const unsigned G = gridDim.x * gridDim.y * gridDim.z;
    unsigned sum, cnt, mine, sp = 0u;
    for (;;) {
        sum = 0u; cnt = 0u; mine = 0u;
#pragma unroll
        for (unsigned j = 0; j < 16; ++j) { const unsigned c = xb_ld(&bar[XB_XCNT(j)]); sum += c; cnt += (c > 0u) ? 1u : 0u; mine = (j == x) ? c : mine; }
        if (sum == G) break;
        __builtin_amdgcn_s_sleep(1);
        if ((++sp & 255u) == 0u) { if (xb_ld(&bar[XB_TMO])) break; if (sp > XB_SPIN_CAP) { atomicAdd(&bar[XB_TMO], 1u); break; } }
    }
    nloc = mine > 0u ? mine : 1u; nx = cnt > 0u ? cnt : 1u;
}
__device__ __forceinline__ void xcd_barrier(const XcdBarrier& b) {
    asm volatile("s_waitcnt vmcnt(0)" ::: "memory");
    __syncthreads();
    if (threadIdx.x == 0) {
        unsigned* bar = b.bar;
        __builtin_amdgcn_s_waitcnt(0);
        unsigned nloc = b.st[0], nx = b.st[1];
        if (nloc == 0u) { xcd_barrier_complete(bar, b.x, nloc, nx); b.st[0] = nloc; b.st[1] = nx; }
        const unsigned old = xb_add(&bar[XB_XSUB(b.x)], 1u);
        const unsigned gen = old / nloc;
        if (old + 1u == (gen + 1u) * nloc) {
            __builtin_amdgcn_fence(__ATOMIC_RELEASE, "agent");
            asm volatile("s_waitcnt vmcnt(0)" ::: "memory");
            const unsigned og = xb_add(&bar[XB_TOP], 1u);
            const unsigned tg = og / nx;
            if (og + 1u == (tg + 1u) * nx) xb_add(&bar[XB_TOPGEN], 1u);
            else XB_SPIN(xb_ld(&bar[XB_TOPGEN]) == tg, bar);
            __builtin_amdgcn_fence(__ATOMIC_ACQUIRE, "agent");
            xb_add(&bar[XB_XGEN(b.x)], 1u);
            asm volatile("s_waitcnt vmcnt(0)" ::: "memory");
        } else {
            XB_SPIN(xb_ld(&bar[XB_XGEN(b.x)]) == gen, bar);
            __builtin_amdgcn_fence(__ATOMIC_ACQUIRE, "agent");
            asm volatile("s_waitcnt vmcnt(0)" ::: "memory");
        }
    }
    __syncthreads();
}
constexpr int MISC_OFF = 160 * 1024 - 64;
constexpr size_t CTL_ZERO_BYTES = 65536;

__global__ void __launch_bounds__(512) hymba_fwd(Params P) {
    extern __shared__ __attribute__((aligned(16))) unsigned char lds[];
    PG8_LAS unsigned char* lds3 = (PG8_LAS unsigned char*)lds;
    unsigned char* ws = P.ws;
    const int lo = P.ph_lo, hi = P.ph_hi;
    const int G = gridDim.x;
#define IN(k) (lo <= (k) && (k) < hi)
#define SEAM(k) do { if (IN(k) && IN((k) + 1)) { xcd_barrier(xbar); } } while (0)
    { volatile LAS unsigned* misc = (volatile LAS unsigned*)(lds3 + MISC_OFF); if (threadIdx.x < 16) misc[threadIdx.x] = 0u; }
    __syncthreads();
    if (hi > NPHASE + 1000) cg::this_grid().sync();
    XcdBarrier xbar = xcd_barrier_post((unsigned*)(ws + 16384), (volatile LAS unsigned*)(lds3 + MISC_OFF));
#define TIDX() int tid = threadIdx.x; asm volatile("" : "+v"(tid)); const int lane = tid & 63, wave = __builtin_amdgcn_readfirstlane(tid >> 6); const int gw = blockIdx.x * 8 + wave, NGW = G * 8; (void)lane; (void)gw; (void)NGW
    typedef pg8::bf16_t bt;
    if (IN(0)) { TIDX(); phase0(P, lds, gw, NGW, wave, lane); } SEAM(0);
    if (IN(1)) {
        pg8::Gemm g{(const bt*)(ws + WS_HN), (const bt*)(ws + WS_WIN), MP, INWP, 1024, 1024, 1024}; pg8::StaticOrder S; S.init(MP, INWP, G, (int)blockIdx.x);
        pg8::EpiInProj E{(bt*)(ws + WS_LAT), (bt*)(ws + WS_Z), (bt*)(ws + WS_XBC), (float*)(ws + WS_DT), P.dt_bias};
        pg8::gemm_phase<pg8::EpiInProj, pg8::StaticOrder, true, true>(lds3, g, S, E);
        { TIDX(); __syncthreads();
          const int nextra = S.nwg % G;
          if (nextra > 0 && nextra < G) { if ((int)blockIdx.x >= nextra) { const int hw = ((int)blockIdx.x - nextra) * 8 + wave, nhw = (G - nextra) * 8;
                  convert_weights(P, lds, hw, nhw, wave, lane, W_ITEMS_IN, W_ITEMS_ALL); build_rope(P, hw, nhw, lane); } }
          else { convert_weights(P, lds, gw, NGW, wave, lane, W_ITEMS_IN, W_ITEMS_ALL); build_rope(P, gw, NGW, lane); } }
    } SEAM(1);
    if (IN(2)) { TIDX(); phase_ssd_states(P, lds, tid, wave, lane); } SEAM(2);
    if (IN(3)) { TIDX(); if (wave < 4) phase_scan(P, tid); else phase_latn(P, (int)blockIdx.x * 4 + (wave - 4), G * 4, lane); } SEAM(3);
    if (IN(4)) { TIDX(); phase_ssd_y(P, lds, tid, wave, lane); } SEAM(4);
    if (IN(5)) {
        { pg8::Gemm g{(const bt*)(ws + WS_LAT), (const bt*)(ws + WS_WQ), MP, QW, 384, LATW, 384}; pg8::StaticOrder S; S.init(MP, QW, G, (int)blockIdx.x);
          pg8::EpiBf16<0> E{(bt*)(ws + WS_Q), QW, QSCALE}; pg8::gemm_phase<pg8::EpiBf16<0>, pg8::StaticOrder, true, true>(lds3, g, S, E); }
        __syncthreads();
        { pg8::Gemm g{(const bt*)(ws + WS_LAT) + 384, (const bt*)(ws + WS_WK), MP, 1024, 256, LATW, 256}; pg8::StaticOrder S; S.init(MP, 1024, G, (int)((blockIdx.x + 120u) % (unsigned)G));
          pg8::EpiBf16<0> E{(bt*)(ws + WS_K), 1024, 1.f}; pg8::gemm_phase<pg8::EpiBf16<0>, pg8::StaticOrder, true, true>(lds3, g, S, E); }
        __syncthreads();
        { pg8::Gemm g{(const bt*)(ws + WS_WV), (const bt*)(ws + WS_LAT) + 384, 1024, MP, 256, 256, LATW}; pg8::StaticOrder S; S.init(1024, MP, G, (int)((blockIdx.x + 112u) % (unsigned)G));
          pg8::EpiBf16<0> E{(bt*)(ws + WS_VT), MP, 1.f}; pg8::gemm_phase<pg8::EpiBf16<0>, pg8::StaticOrder, true, true>(lds3, g, S, E); }
    } SEAM(5);
    if (IN(6)) { TIDX();
        if (wave >= 4) __builtin_amdgcn_s_setprio(1);
        att::phase(P, lds, tid, wave, lane);
        if (wave >= 4) __builtin_amdgcn_s_setprio(0);
    } SEAM(6);
    if (IN(7)) {
        pg8::Gemm g{(const bt*)(ws + WS_MIX) + (size_t)NMETA * 2048, (const bt*)(ws + WS_WOUT), SEQ, 1024, 2048, 2048, 2048}; pg8::StaticOrder S; S.init(SEQ, 1024, G, (int)blockIdx.x);
        pg8::EpiBf16<0> E{(bt*)(ws + WS_MIXO), 1024, 1.f}; pg8::gemm_phase<pg8::EpiBf16<0>, pg8::StaticOrder, false, true>(lds3, g, S, E);
    } SEAM(7);
    if (IN(8)) { TIDX(); phase_rows1(P, gw, NGW, lane); } SEAM(8);
    if (IN(9)) {
        pg8::Gemm g{(const bt*)(ws + WS_HN2), (const bt*)(ws + WS_WUP), SEQ, DFF, 1024, 1024, 1024}; pg8::StaticOrder S; S.init(SEQ, DFF, G, (int)blockIdx.x);
        pg8::EpiBf16<2> E{(bt*)(ws + WS_FF), DFF, 1.f}; pg8::gemm_phase<pg8::EpiBf16<2>, pg8::StaticOrder, true, true>(lds3, g, S, E);
    } SEAM(9);
    if (IN(10)) {
        pg8::Gemm g{(const bt*)(ws + WS_FF), (const bt*)(ws + WS_WDN), SEQ, 1024, DFF, DFF, DFF}; pg8::StaticOrder S; S.init(SEQ, 1024, G, (int)blockIdx.x);
        pg8::EpiBf16<0> E{(bt*)(ws + WS_F), 1024, 1.f}; pg8::gemm_phase<pg8::EpiBf16<0>, pg8::StaticOrder, false, true>(lds3, g, S, E);
    } SEAM(10);
    if (IN(11)) { TIDX(); phase_rows2(P, gw, NGW, lane); }
#undef IN
#undef SEAM
#undef TIDX
}

extern "C" void kernel_launch(void* const* d_in, const int* in_sizes, int n_in, void* d_out, int out_size, void* d_ws, size_t ws_size, hipStream_t stream) {
    static int grid = 0;
    if (grid == 0) {
        int dev = 0, cus = 0, per_cu = 0;
        (void)hipGetDevice(&dev); (void)hipDeviceGetAttribute(&cus, hipDeviceAttributeMultiprocessorCount, dev);
        if (hipFuncSetAttribute((const void*)hymba_fwd, hipFuncAttributeMaxDynamicSharedMemorySize, LDS_BYTES) != hipSuccess) { fprintf(stderr, "hipFuncSetAttribute failed\n"); }
        if (hipOccupancyMaxActiveBlocksPerMultiprocessor(&per_cu, (const void*)hymba_fwd, 512, LDS_BYTES) != hipSuccess || per_cu < 1) { fprintf(stderr, "occupancy query: %d\n", per_cu); per_cu = 1; }
        (void)hipGetLastError();
        grid = cus * 1;
        if (ws_size < 256 * MiB) { fprintf(stderr, "workspace too small: %zu\n", ws_size); grid = -1; }
    }
    if (grid < 0) return;
    Params p{};
    const float** pp = (const float**)&p;
    for (int i = 0; i < 20; ++i) pp[i] = (const float*)d_in[i];
    p.out = (float*)d_out; p.ws = (unsigned char*)d_ws;
    for (int j = 0; j < 32; ++j) p.invf[j] = (float)pow(10000.0, -(double)(2 * j) / 64.0);
#if ONE_LAUNCH
    p.ph_lo = 0; p.ph_hi = NPHASE;
    if (hipMemsetAsync(d_ws, 0, CTL_ZERO_BYTES, stream) != hipSuccess) { fprintf(stderr, "memset of the barrier words failed\n"); return; }
    void* args[] = {&p};
    hipError_t e = hipLaunchCooperativeKernel((const void*)hymba_fwd, dim3(grid), dim3(512), args, LDS_BYTES, stream);
    if (e != hipSuccess) fprintf(stderr, "cooperative launch failed: %s (grid %d)\n", hipGetErrorString(e), grid);
#else
    for (int ph = 0; ph < NPHASE; ++ph) { p.ph_lo = ph; p.ph_hi = ph + 1; hipLaunchKernelGGL(hymba_fwd, dim3(grid), dim3(512), LDS_BYTES, stream, p); }
#endif
}
```

```cpp
#include <hip/hip_runtime.h>
#include <hip/hip_cooperative_groups.h>
#include <cstdio>
#include <cstdint>
#include <cmath>
namespace cg = cooperative_groups;

#ifndef ONE_LAUNCH
#define ONE_LAUNCH 1
#endif

namespace pg8 {
#define PG8_LAS __attribute__((address_space(3)))
typedef unsigned short bf16_t;
typedef short bf16x8 __attribute__((ext_vector_type(8)));
typedef float f32x4 __attribute__((ext_vector_type(4)));
typedef unsigned u32x4 __attribute__((ext_vector_type(4)));
constexpr int BM = 256, BK = 64, HALF = 128, HTB = HALF * BK * 2, STAGE_BYTES = 8 * HTB, NXCD = 8, WGM = 8;

__host__ __device__ __forceinline__ int lds_byte(int r, int c) { const int st = (r >> 4) * 2 + (c >> 5), rr = r & 15, cc = c & 31, ob = rr * 64 + cc * 2; return st * 1024 + (ob ^ (((ob >> 9) & 1) << 5)); }
__host__ __device__ __forceinline__ void stage_rc(int b, int& R, int& C) { const int st = b / 1024, sb = b % 1024, swz = sb ^ (((sb >> 9) & 1) << 5); R = (st >> 1) * 16 + swz / 64; C = (st & 1) * 32 + (swz % 64) / 2; }
__host__ __device__ __forceinline__ int perm32(int rho) { const int n = rho >> 4, i = rho & 15; return 8 * (i >> 2) + 4 * n + (i & 3); }

struct Unit { int pm, pn; };
struct Gemm { const bf16_t* A; const bf16_t* Bt; int M, N, K, lda, ldb; };

struct StaticOrder {
    int nM, nN, nwg, G, c;
    __host__ __device__ void init(int M, int N, int G_, int c_) { nM = M / BM; nN = N / BM; nwg = nM * nN; G = G_; c = c_; }
    __host__ __device__ bool next(int i, Unit& u) const {
        const long L = (long)i * G + c; if (L >= nwg) return false;
        int wgid = (int)L; { const int q = nwg / NXCD, r = nwg % NXCD, xcd = wgid % NXCD, off = wgid / NXCD; wgid = (xcd < r ? xcd * (q + 1) : r * (q + 1) + (xcd - r) * q) + off; }
        const int nig = WGM * nN, gid = wgid / nig, fm = gid * WGM, gsz = (nM - fm) < WGM ? (nM - fm) : WGM;
        u.pm = fm + ((wgid % nig) % gsz); u.pn = (wgid % nig) / gsz; return true;
    }
    __device__ __forceinline__ void a_ready(const Unit&) const {}
    __device__ __forceinline__ void done(const Unit&) const {}
};

typedef float f32x2_t __attribute__((ext_vector_type(2))); typedef __bf16 bf16x2_t __attribute__((ext_vector_type(2)));
__device__ __forceinline__ unsigned cvt_pk_bf16(float lo, float hi) { f32x2_t v = {lo, hi}; bf16x2_t b = __builtin_convertvector(v, bf16x2_t); return __builtin_bit_cast(unsigned, b); }

template <int ACT  > struct EpiBf16 {
    static constexpr bool PERM = true, AFTER_DRAIN = false;
    bf16_t* O; int ldc; float scale;
    __device__ __forceinline__ void operator()(const f32x4 (&acc)[2][2][4][2], const Unit& u, int wr, int wc, int fr, int fq) const {
        const int row0 = u.pm * BM + wr * 64 + fr; const int col0 = u.pn * BM + wc * 32 + 8 * fq;
#pragma unroll
        for (int ai = 0; ai < 2; ++ai)
#pragma unroll
            for (int m = 0; m < 4; ++m) { bf16_t* rowp = O + (size_t)(row0 + ai * HALF + m * 16) * ldc + col0;
#pragma unroll
                for (int bj = 0; bj < 2; ++bj) { f32x4 v0 = acc[ai][bj][m][0], v1 = acc[ai][bj][m][1];
                    if (ACT == 2) {
#pragma unroll
                        for (int i = 0; i < 4; ++i) { float a = v0[i] > 0.f ? v0[i] : 0.f; v0[i] = a * a; float b = v1[i] > 0.f ? v1[i] : 0.f; v1[i] = b * b; } }
                    v0 = v0 * scale; v1 = v1 * scale; u32x4 w; w.x = cvt_pk_bf16(v0[0], v0[1]); w.y = cvt_pk_bf16(v0[2], v0[3]); w.z = cvt_pk_bf16(v1[0], v1[1]); w.w = cvt_pk_bf16(v1[2], v1[3]);
                    *(u32x4*)(rowp + bj * HALF) = w; } }
    }
};
struct EpiF32 {
    static constexpr bool PERM = true, AFTER_DRAIN = false;
    float* O; int ldc;
    __device__ __forceinline__ void operator()(const f32x4 (&acc)[2][2][4][2], const Unit& u, int wr, int wc, int fr, int fq) const {
        const int row0 = u.pm * BM + wr * 64 + fr; const int col0 = u.pn * BM + wc * 32 + 8 * fq;
#pragma unroll
        for (int ai = 0; ai < 2; ++ai)
#pragma unroll
            for (int m = 0; m < 4; ++m) { float* rowp = O + (size_t)(row0 + ai * HALF + m * 16) * ldc + col0;
#pragma unroll
                for (int bj = 0; bj < 2; ++bj) { *(f32x4*)(rowp + bj * HALF) = acc[ai][bj][m][0]; *(f32x4*)(rowp + bj * HALF + 4) = acc[ai][bj][m][1]; } }
    }
};
struct EpiInProj {
    static constexpr bool PERM = true, AFTER_DRAIN = false;
    bf16_t* lat; bf16_t* z; bf16_t* xbc; float* dt; const float* dt_bias;
    __device__ __forceinline__ void operator()(const f32x4 (&acc)[2][2][4][2], const Unit& u, int wr, int wc, int fr, int fq) const {
        const int row0 = u.pm * BM + wr * 64 + fr; const int colb = u.pn * BM + wc * 32 + 8 * fq;
#pragma unroll
        for (int ai = 0; ai < 2; ++ai)
#pragma unroll
            for (int m = 0; m < 4; ++m) { const size_t row = (size_t)(row0 + ai * HALF + m * 16);
#pragma unroll
                for (int bj = 0; bj < 2; ++bj) { const int col = colb + bj * HALF; const f32x4 v0 = acc[ai][bj][m][0], v1 = acc[ai][bj][m][1];
                    if (col < 3264) {
                        u32x4 w; w.x = cvt_pk_bf16(v0[0], v0[1]); w.y = cvt_pk_bf16(v0[2], v0[3]); w.z = cvt_pk_bf16(v1[0], v1[1]); w.w = cvt_pk_bf16(v1[2], v1[3]);
                        bf16_t* p;
                        if (col < 704) p = lat + row * 704 + col; else if (col < 1728) p = z + row * 1024 + (col - 704); else p = xbc + row * 1536 + (col - 1728);
                        *(u32x4*)p = w;
                    } else if (col < 3280) {
                        const int c0 = col - 3264; f32x4 o0, o1;
#pragma unroll
                        for (int i = 0; i < 4; ++i) { float a = v0[i] + dt_bias[c0 + i]; o0[i] = fmaxf(a, 0.f) + log1pf(__expf(-fabsf(a))); float b = v1[i] + dt_bias[c0 + 4 + i]; o1[i] = fmaxf(b, 0.f) + log1pf(__expf(-fabsf(b))); }
                        *(f32x4*)(dt + row * 16 + c0) = o0; *(f32x4*)(dt + row * 16 + c0 + 4) = o1;
                    } } }
    }
};

template <class Epi, class Sched, bool ALIGN_EPI = false, bool SP2 = false>
__device__ __forceinline__ void gemm_phase(PG8_LAS unsigned char* lds, const Gemm g, const Sched& S, const Epi& E) {
    int tid = threadIdx.x; asm volatile("" : "+v"(tid));
    const int wid = __builtin_amdgcn_readfirstlane(tid >> 6), lane = tid & 63, wr = wid >> 2, wc = wid & 3, fr = lane & 15, fq = lane >> 4;
    const int K = g.K, nt = K / BK;
    unsigned voffA[2], voffB[2];
#pragma unroll
    for (int i = 0; i < 2; ++i) { int R, C; stage_rc(tid * 16 + i * 8192, R, C); const int Rb = Epi::PERM ? ((R & ~31) + perm32(R & 31)) : R;
        voffA[i] = (unsigned)(R * g.lda + C) * 2u; voffB[i] = (unsigned)(Rb * g.ldb + C) * 2u; }
    const size_t kstep = (size_t)(BK * 2);
    const size_t hstepA = (size_t)HALF * g.lda * 2, hstepB = (size_t)HALF * g.ldb * 2;
    const size_t tstepA = 2 * hstepA, tstepB = 2 * hstepB;
    const unsigned ldsw = (unsigned)wid * 1024u;
    const int aoff = lds_byte(wr * 64 + fr, fq * 8), boff = lds_byte(wc * 32 + fr, fq * 8);
#define PG8_SA(b, h) (((b) * 2 + (h)) * HTB)
#define PG8_SB(b, h) ((4 + (b) * 2 + (h)) * HTB)
#define PG8_STAGE(bufoff, gbase, voff) do { _Pragma("unroll") for (int _i = 0; _i < 2; ++_i) \
        __builtin_amdgcn_global_load_lds((const unsigned*)((const char*)(gbase) + (voff)[_i]), (PG8_LAS unsigned*)(lds + (bufoff) + ldsw + _i * 8192), 16, 0, 0); } while (0)
#define PG8_LDA(dst, b, h) do { _Pragma("unroll") for (int m = 0; m < 4; ++m) _Pragma("unroll") for (int k = 0; k < 2; ++k) dst[m][k] = *(const PG8_LAS bf16x8*)(lds + PG8_SA(b, h) + aoff + m * 2048 + k * 1024); } while (0)
#define PG8_LDB(dst, b, h) do { _Pragma("unroll") for (int n = 0; n < 2; ++n) _Pragma("unroll") for (int k = 0; k < 2; ++k) dst[n][k] = *(const PG8_LAS bf16x8*)(lds + PG8_SB(b, h) + boff + n * 2048 + k * 1024); } while (0)
#define PG8_MMA(ai, bj, At, Bt) do { __builtin_amdgcn_s_setprio(1); _Pragma("unroll") for (int m = 0; m < 4; ++m) _Pragma("unroll") for (int n = 0; n < 2; ++n) _Pragma("unroll") for (int k = 0; k < 2; ++k) \
        acc[ai][bj][m][n] = __builtin_amdgcn_mfma_f32_16x16x32_bf16(Bt[n][k], At[m][k], acc[ai][bj][m][n], 0, 0, 0); __builtin_amdgcn_s_setprio(0); } while (0)
#define PG8_WAIT_V(n) asm volatile("s_waitcnt vmcnt(" #n ")" ::: "memory")
#define PG8_WAIT_L(n) asm volatile("s_waitcnt lgkmcnt(" #n ")" ::: "memory")
#define PG8_BAR __builtin_amdgcn_s_barrier()
#define PG8_SCHED __builtin_amdgcn_sched_barrier(0)
    Unit cur, nxt; int ui = 0;
    if (!S.next(0, cur)) return;
    f32x4 acc[2][2][4][2];
#pragma unroll
    for (int a = 0; a < 2; ++a)
#pragma unroll
        for (int b = 0; b < 2; ++b)
#pragma unroll
            for (int m = 0; m < 4; ++m)
#pragma unroll
                for (int n = 0; n < 2; ++n) acc[a][b][m][n] = (f32x4){0.f, 0.f, 0.f, 0.f};
    bf16x8 At[4][2], B0[2][2], B1[2][2];
    const char* cA = (const char*)g.A + (size_t)cur.pm * tstepA; const char* cB = (const char*)g.Bt + (size_t)cur.pn * tstepB;
    S.a_ready(cur);
    if constexpr (SP2) {
        PG8_STAGE(PG8_SB(0, 0), cB, voffB); PG8_STAGE(PG8_SB(0, 1), cB + hstepB, voffB); PG8_STAGE(PG8_SA(0, 0), cA, voffA); PG8_STAGE(PG8_SA(0, 1), cA + hstepA, voffA);
        if (wr == 1) PG8_BAR;
        PG8_WAIT_V(2); PG8_BAR;
        PG8_STAGE(PG8_SB(1, 0), cB + kstep, voffB); PG8_STAGE(PG8_SA(1, 0), cA + kstep, voffA); PG8_STAGE(PG8_SB(1, 1), cB + hstepB + kstep, voffB);
        PG8_WAIT_V(6); PG8_BAR;
    } else {
        PG8_STAGE(PG8_SB(0, 0), cB, voffB); PG8_STAGE(PG8_SA(0, 0), cA, voffA); PG8_STAGE(PG8_SB(0, 1), cB + hstepB, voffB); PG8_STAGE(PG8_SA(0, 1), cA + hstepA, voffA);
        if (wr == 1) PG8_BAR;
        PG8_WAIT_V(4); PG8_BAR;
        PG8_STAGE(PG8_SB(1, 0), cB + kstep, voffB); PG8_STAGE(PG8_SA(1, 0), cA + kstep, voffA); PG8_STAGE(PG8_SB(1, 1), cB + hstepB + kstep, voffB);
        PG8_WAIT_V(6); PG8_BAR;
    }
    for (;;) {
        const bool has_next = S.next(ui + 1, nxt);
        const char* nA = has_next ? (const char*)g.A + (size_t)nxt.pm * tstepA : cA; const char* nB = has_next ? (const char*)g.Bt + (size_t)nxt.pn * tstepB : cB;
        for (int t = 0; t < nt; t += 2) {
            const bool last = (t == nt - 2);
            const char* a1 = cA + (size_t)(t + 1) * kstep;
            const char* a2 = last ? nA : cA + (size_t)(t + 2) * kstep; const char* b2 = last ? nB : cB + (size_t)(t + 2) * kstep;
            const char* a3 = a2 + kstep; const char* b3 = b2 + kstep;
            if (last && has_next) S.a_ready(nxt);
            if constexpr (SP2) {
            PG8_LDB(B0, 0, 0); PG8_LDB(B1, 0, 1); PG8_SCHED; PG8_LDA(At, 0, 0); PG8_STAGE(PG8_SA(1, 1), a1 + hstepA, voffA);
            PG8_WAIT_V(8); PG8_WAIT_L(0); PG8_BAR; PG8_MMA(0, 0, At, B0); PG8_MMA(0, 1, At, B1); PG8_BAR; PG8_SCHED;
            PG8_LDA(At, 0, 1); PG8_STAGE(PG8_SB(0, 0), b2, voffB); PG8_STAGE(PG8_SB(0, 1), b2 + hstepB, voffB); PG8_STAGE(PG8_SA(0, 0), a2, voffA);
            PG8_WAIT_V(8); PG8_WAIT_L(0); PG8_BAR; PG8_MMA(1, 0, At, B0); PG8_MMA(1, 1, At, B1); PG8_BAR; PG8_SCHED;
            PG8_LDB(B0, 1, 0); PG8_LDB(B1, 1, 1); PG8_SCHED; PG8_LDA(At, 1, 0); PG8_STAGE(PG8_SA(0, 1), a2 + hstepA, voffA);
            PG8_WAIT_V(8); PG8_WAIT_L(0); PG8_BAR; PG8_MMA(0, 0, At, B0); PG8_MMA(0, 1, At, B1); PG8_BAR; PG8_SCHED;
            PG8_LDA(At, 1, 1); PG8_STAGE(PG8_SB(1, 0), b3, voffB); PG8_STAGE(PG8_SB(1, 1), b3 + hstepB, voffB); PG8_STAGE(PG8_SA(1, 0), a3, voffA);
            PG8_WAIT_V(8); PG8_WAIT_L(0); PG8_BAR; PG8_MMA(1, 0, At, B0); PG8_MMA(1, 1, At, B1); PG8_BAR; PG8_SCHED;
            } else {
            PG8_LDB(B0, 0, 0); PG8_SCHED; PG8_LDA(At, 0, 0); PG8_STAGE(PG8_SA(1, 1), a1 + hstepA, voffA);
            PG8_WAIT_L(8); PG8_BAR; PG8_WAIT_L(0); PG8_MMA(0, 0, At, B0); PG8_BAR; PG8_SCHED;
            PG8_LDB(B1, 0, 1); PG8_STAGE(PG8_SB(0, 0), b2, voffB);
            PG8_BAR; PG8_WAIT_L(0); PG8_MMA(0, 1, At, B1); PG8_BAR;
            PG8_LDA(At, 0, 1); PG8_STAGE(PG8_SA(0, 0), a2, voffA);
            PG8_BAR; PG8_WAIT_L(0); PG8_MMA(1, 0, At, B0); PG8_BAR; PG8_SCHED;
            PG8_STAGE(PG8_SB(0, 1), b2 + hstepB, voffB);
            PG8_WAIT_V(6); PG8_BAR; PG8_MMA(1, 1, At, B1); PG8_BAR;
            PG8_LDB(B0, 1, 0); PG8_SCHED; PG8_LDA(At, 1, 0); PG8_STAGE(PG8_SA(0, 1), a2 + hstepA, voffA);
            PG8_WAIT_L(8); PG8_BAR; PG8_WAIT_L(0); PG8_MMA(0, 0, At, B0); PG8_BAR; PG8_SCHED;
            PG8_LDB(B1, 1, 1); PG8_STAGE(PG8_SB(1, 0), b3, voffB);
            PG8_BAR; PG8_WAIT_L(0); PG8_MMA(0, 1, At, B1); PG8_BAR;
            PG8_LDA(At, 1, 1); PG8_STAGE(PG8_SA(1, 0), a3, voffA);
            PG8_BAR; PG8_WAIT_L(0); PG8_MMA(1, 0, At, B0); PG8_BAR; PG8_SCHED;
            PG8_STAGE(PG8_SB(1, 1), b3 + hstepB, voffB);
            PG8_WAIT_V(6); PG8_BAR; PG8_MMA(1, 1, At, B1); PG8_BAR;
            }
        }
        if constexpr (ALIGN_EPI) { if (wr == 0) PG8_BAR; }
        if constexpr (!Epi::AFTER_DRAIN) { E(acc, cur, wr, wc, fr, fq); S.done(cur); }
        if (!has_next) break;
#pragma unroll
        for (int a = 0; a < 2; ++a)
#pragma unroll
            for (int b = 0; b < 2; ++b)
#pragma unroll
                for (int m = 0; m < 4; ++m)
#pragma unroll
                    for (int n = 0; n < 2; ++n) acc[a][b][m][n] = (f32x4){0.f, 0.f, 0.f, 0.f};
        cur = nxt; cA = nA; cB = nB; ++ui;
        if constexpr (ALIGN_EPI) { if (wr == 1) PG8_BAR; }
    }
    PG8_WAIT_V(0);
    if constexpr (!ALIGN_EPI) { if (wr == 0) PG8_BAR; }
    PG8_BAR;
#undef PG8_SA
#undef PG8_SB
#undef PG8_STAGE
#undef PG8_LDA
#undef PG8_LDB
#undef PG8_MMA
#undef PG8_WAIT_V
#undef PG8_WAIT_L
#undef PG8_BAR
#undef PG8_SCHED
}
}

typedef unsigned short bf16_t;
typedef short bf16x8 __attribute__((ext_vector_type(8)));
typedef float f32x16 __attribute__((ext_vector_type(16)));
typedef float f32x4 __attribute__((ext_vector_type(4)));
typedef unsigned u32x4 __attribute__((ext_vector_type(4)));
typedef unsigned u32x2 __attribute__((ext_vector_type(2)));

constexpr int DM = 1024, SEQ = 16384, NMETA = 16, L = SEQ + NMETA  , MP = 16640  ;
constexpr int INW = 3280, INWP = 3328, LATW = 704, QW = 1536, XBCW = 1536, DFF = 4096;
constexpr int NCH = 129;
constexpr float EPS = 1e-6f;
constexpr float QSCALE = 0.07216878364870322f * 1.4426950408889634f;
constexpr size_t MiB = 1u << 20;
constexpr size_t WS_WIN = 1 * MiB, WS_WQ = WS_WIN + (size_t)INWP * 1024 * 2, WS_WK = WS_WQ + (size_t)1536 * 384 * 2, WS_WV = WS_WK + (size_t)1024 * 256 * 2;
constexpr size_t WS_WOUT = 10 * MiB, WS_WUP = 14 * MiB, WS_WDN = 22 * MiB;
constexpr size_t WS_DT = 30 * MiB, WS_CDEC = 31 * MiB + 512 * 1024, WS_ROPE = 32 * MiB;
constexpr size_t WS_MIX = 37 * MiB;
constexpr size_t WS_HN = 37 * MiB;
constexpr size_t WS_LAT = 102 * MiB;
constexpr size_t WS_Z = 124 * MiB + 512 * 1024;
constexpr size_t WS_XBC = 157 * MiB;
constexpr size_t WS_ST = 205 * MiB + 768 * 1024;
constexpr size_t WS_KR = 253 * MiB;
constexpr size_t WS_BCONV = 238 * MiB + 512 * 1024;
static_assert(WS_BCONV + (size_t)MP * 256 * 2 <= WS_KR, "bconv");
constexpr size_t WS_Q = WS_Z;
constexpr size_t WS_K = 173 * MiB + 256 * 1024;
constexpr size_t WS_VT = 205 * MiB + 768 * 1024;
constexpr size_t WS_MIXO = 102 * MiB;
constexpr size_t WS_HN2 = 224 * MiB;
constexpr size_t WS_FF = 37 * MiB;
constexpr size_t WS_F = 165 * MiB;
static_assert(WS_WV + (size_t)1024 * 256 * 2 <= WS_WOUT, "w");
static_assert(WS_ROPE + (size_t)L * 32 * 8 <= WS_MIX, "rope");
static_assert(WS_MIX + (size_t)MP * 2048 * 2 <= WS_LAT, "mix");
static_assert(WS_LAT + (size_t)MP * 704 * 2 <= WS_Z, "lat");
static_assert(WS_Z + (size_t)MP * 1024 * 2 <= WS_XBC, "z");
static_assert(WS_XBC + (size_t)MP * 1536 * 2 <= WS_ST, "xbc");
static_assert(WS_ST + (size_t)NCH * 131072 * 2 <= WS_KR, "st");
static_assert(WS_KR + (size_t)MP * 64 * 2 <= 256 * MiB, "kr");
static_assert(WS_Q + (size_t)MP * 1536 * 2 <= WS_K && WS_K + (size_t)MP * 1024 * 2 <= WS_VT && WS_VT + (size_t)1024 * MP * 2 <= WS_KR, "qkv");
static_assert(WS_MIXO + (size_t)SEQ * 1024 * 4 <= WS_HN2 && WS_FF + (size_t)SEQ * 4096 * 2 <= WS_F && WS_F + (size_t)SEQ * 1024 * 4 <= 256 * MiB, "tail");

constexpr int LDS_BYTES = 160 * 1024;
constexpr int NPHASE = 12;

struct Params {
    const float *x, *meta, *g_mix_pre, *w_in, *g_qa, *w_q_up, *g_kva, *w_kv_up, *conv_w, *conv_b, *dt_bias, *a_log, *d_skip, *g_ssm, *w_out, *g_mix_post, *g_mlp_pre, *w_up, *w_dn, *g_mlp_post;
    float* out; unsigned char* ws;
    float invf[32];
    int ph_lo, ph_hi;
};

__device__ __forceinline__ float bf_lo(unsigned u) { return __uint_as_float(u << 16); }
__device__ __forceinline__ float bf_hi(unsigned u) { return __uint_as_float(u & 0xffff0000u); }
__device__ __forceinline__ float bf2f(bf16_t b) { return __uint_as_float(((unsigned)b) << 16); }
__device__ __forceinline__ unsigned pk2(float lo, float hi) { return pg8::cvt_pk_bf16(lo, hi); }
__device__ __forceinline__ bf16_t f2bf(float f) { return (bf16_t)(pk2(f, 0.f) & 0xffffu); }
__device__ __forceinline__ float wave_sum(float v) {
#pragma unroll
    for (int o = 1; o < 64; o <<= 1) v += __shfl_xor(v, o);
    return v;
}
__device__ __forceinline__ float silu(float v) { return v * __builtin_amdgcn_rcpf(1.f + __expf(-v)); }

__device__ __forceinline__ void p0_transpose_item(const float* W, int K, int ldsrc, bf16_t* WT, float* scr, int k0, int n0, int scol0, int nvalid, int lane) {
    const bool ok = (n0 + (lane & 31)) < nvalid;
#pragma unroll 8
    for (int i = 0; i < 32; ++i) { const int kk = 2 * i + (lane >> 5); scr[kk * 33 + (lane & 31)] = ok ? W[(size_t)(k0 + kk) * ldsrc + scol0 + (lane & 31)] : 0.f; }
    __builtin_amdgcn_s_waitcnt(0); asm volatile("" ::: "memory");
    const int c = lane & 7;
#pragma unroll
    for (int j = 0; j < 4; ++j) { const int n = (lane >> 3) + 8 * j; const float* s = scr + (8 * c) * 33 + n;
        u32x4 o; o.x = pk2(s[0 * 33], s[1 * 33]); o.y = pk2(s[2 * 33], s[3 * 33]); o.z = pk2(s[4 * 33], s[5 * 33]); o.w = pk2(s[6 * 33], s[7 * 33]);
        *(u32x4*)(WT + (size_t)(n0 + n) * K + k0 + 8 * c) = o; }
    __builtin_amdgcn_s_waitcnt(0); asm volatile("" ::: "memory");
}

__device__ __forceinline__ void sincos_acc(float a, float& c, float& s) {
    const double x = (double)a; const double k = rint(x * 0.63661977236758134308);
    const double r = fma(-k, 1.57079632679489661923, x), r2 = r * r;
    double sp = -2.5052108385441718775e-8; sp = sp * r2 + 2.7557319223985890653e-6; sp = sp * r2 - 1.9841269841269841270e-4; sp = sp * r2 + 8.3333333333333333333e-3; sp = sp * r2 - 1.6666666666666666667e-1; sp = r + r * r2 * sp;
    double cp = 2.0876756987868098979e-9; cp = cp * r2 - 2.7557319223985890653e-7; cp = cp * r2 + 2.4801587301587301587e-5; cp = cp * r2 - 1.3888888888888888889e-3; cp = cp * r2 + 4.1666666666666666667e-2; cp = cp * r2 - 0.5; cp = 1.0 + r2 * cp;
    const int q = ((int)k) & 3;
    const double sv = (q == 0) ? sp : (q == 1) ? cp : (q == 2) ? -sp : -cp;
    const double cv = (q == 0) ? cp : (q == 1) ? -sp : (q == 2) ? -cp : sp;
    c = (float)cv; s = (float)sv;
}

__device__ __forceinline__ void convert_weights(const Params& P, unsigned char* lds, int gw, int NGW, int wave, int lane, int it_lo, int it_hi) {
    unsigned char* ws = P.ws;
    float* scr = (float*)(lds + wave * 8704);
    constexpr int I_IN = 16 * 104, I_Q = 6 * 48, I_K = 4 * 32, I_V = 4 * 32, I_O = 32 * 32, I_U = 16 * 128, I_D = 64 * 32;
    for (int it = it_lo + gw; it < it_hi; it += NGW) {
        int r = it;
        if (r < I_IN) { const int kb = r / 104, nb = r % 104; p0_transpose_item(P.w_in, 1024, INW, (bf16_t*)(ws + WS_WIN), scr, kb * 64, nb * 32, nb * 32, INW, lane); continue; } r -= I_IN;
        if (r < I_Q) { const int kb = r / 48, nb = r % 48; p0_transpose_item(P.w_q_up, 384, 1536, (bf16_t*)(ws + WS_WQ), scr, kb * 64, nb * 32, nb * 32, 1536, lane); continue; } r -= I_Q;
        if (r < I_K) { const int kb = r / 32, nb = r % 32, n0 = nb * 32; p0_transpose_item(P.w_kv_up, 256, 2048, (bf16_t*)(ws + WS_WK), scr, kb * 64, n0, 256 * (n0 >> 7) + (n0 & 127), 1024, lane); continue; } r -= I_K;
        if (r < I_V) { const int kb = r / 32, nb = r % 32, n0 = nb * 32; p0_transpose_item(P.w_kv_up, 256, 2048, (bf16_t*)(ws + WS_WV), scr, kb * 64, n0, 256 * (n0 >> 7) + 128 + (n0 & 127), 1024, lane); continue; } r -= I_V;
        if (r < I_O) { const int kb = r / 32, nb = r % 32; p0_transpose_item(P.w_out, 2048, 1024, (bf16_t*)(ws + WS_WOUT), scr, kb * 64, nb * 32, nb * 32, 1024, lane); continue; } r -= I_O;
        if (r < I_U) { const int kb = r / 128, nb = r % 128; p0_transpose_item(P.w_up, 1024, 4096, (bf16_t*)(ws + WS_WUP), scr, kb * 64, nb * 32, nb * 32, 4096, lane); continue; } r -= I_U;
        { const int kb = r / 32, nb = r % 32; p0_transpose_item(P.w_dn, 4096, 1024, (bf16_t*)(ws + WS_WDN), scr, kb * 64, nb * 32, nb * 32, 1024, lane); }
    }
}
constexpr int W_ITEMS_IN = 16 * 104, W_ITEMS_ALL = 16 * 104 + 6 * 48 + 4 * 32 + 4 * 32 + 32 * 32 + 16 * 128 + 64 * 32;
__device__ __forceinline__ void phase0(const Params& P, unsigned char* lds, int gw, int NGW, int wave, int lane) {
    unsigned char* ws = P.ws;
    convert_weights(P, lds, gw, NGW, wave, lane, 0, W_ITEMS_IN);
    bf16_t* hn = (bf16_t*)(ws + WS_HN);
    for (int m = gw; m < MP; m += NGW) {
        unsigned long long* o8 = (unsigned long long*)(hn + (size_t)m * DM) + lane;
        if (m >= L) {
#pragma unroll
            for (int j = 0; j < 4; ++j) o8[64 * j] = 0ull;
            continue; }
        const float* xrow = (m < NMETA) ? (P.meta + (size_t)m * DM) : (P.x + (size_t)(m - NMETA) * DM);
        const f32x4* xr = (const f32x4*)xrow + lane; const f32x4* gr = (const f32x4*)P.g_mix_pre + lane;
        f32x4 v[4]; float s = 0.f;
#pragma unroll
        for (int j = 0; j < 4; ++j) { v[j] = xr[64 * j]; s += (v[j].x * v[j].x + v[j].y * v[j].y) + (v[j].z * v[j].z + v[j].w * v[j].w); }
        const float rstd = rsqrtf(wave_sum(s) * (1.f / DM) + EPS);
#pragma unroll
        for (int j = 0; j < 4; ++j) { const f32x4 g = gr[64 * j];
            o8[64 * j] = (unsigned long long)pk2(v[j].x * rstd * g.x, v[j].y * rstd * g.y) | ((unsigned long long)pk2(v[j].z * rstd * g.z, v[j].w * rstd * g.w) << 32); }
    }
}
__device__ __forceinline__ void build_rope(const Params& P, int gw, int NGW, int lane) {
    float2* rope = (float2*)(P.ws + WS_ROPE);
    for (int i = gw * 64 + lane; i < L * 32; i += NGW * 64) { const int pos = i >> 5, j = i & 31; const float a = (float)pos * P.invf[j]; float c, s; sincos_acc(a, c, s); rope[i] = make_float2(c, s); }
}

__device__ __forceinline__ void phase_latn(const Params& P, int gw, int NGW, int lane) {
    bf16_t* lat = (bf16_t*)(P.ws + WS_LAT); bf16_t* kr = (bf16_t*)(P.ws + WS_KR); const float2* rope = (const float2*)(P.ws + WS_ROPE);
    for (int m0 = 2 * gw; m0 < MP; m0 += 2 * NGW) {
        float q[2][6], kv[2][4], x1[2], x2[2];
#pragma unroll
        for (int t = 0; t < 2; ++t) { const bf16_t* row = lat + (size_t)(m0 + t) * LATW;
#pragma unroll
            for (int i = 0; i < 6; ++i) q[t][i] = bf2f(row[lane + 64 * i]);
#pragma unroll
            for (int i = 0; i < 4; ++i) kv[t][i] = bf2f(row[384 + lane + 64 * i]);
            x1[t] = 0.f; x2[t] = 0.f; if (lane < 32) { x1[t] = bf2f(row[640 + lane]); x2[t] = bf2f(row[672 + lane]); } }
#pragma unroll
        for (int t = 0; t < 2; ++t) { const int m = m0 + t; bf16_t* row = lat + (size_t)m * LATW;
            float sq = 0.f, sk = 0.f;
#pragma unroll
            for (int i = 0; i < 6; ++i) sq += q[t][i] * q[t][i];
#pragma unroll
            for (int i = 0; i < 4; ++i) sk += kv[t][i] * kv[t][i];
            const float rq = rsqrtf(wave_sum(sq) * (1.f / 384.f) + EPS), rk = rsqrtf(wave_sum(sk) * (1.f / 256.f) + EPS);
#pragma unroll
            for (int i = 0; i < 6; ++i) row[lane + 64 * i] = f2bf(q[t][i] * rq * P.g_qa[lane + 64 * i]);
#pragma unroll
            for (int i = 0; i < 4; ++i) row[384 + lane + 64 * i] = f2bf(kv[t][i] * rk * P.g_kva[lane + 64 * i]);
            if (lane < 32) {
                float o1 = 0.f, o2 = 0.f;
                if (m < L) { const float2 cs = rope[m * 32 + lane]; o1 = x1[t] * cs.x - x2[t] * cs.y; o2 = x2[t] * cs.x + x1[t] * cs.y; }
                kr[(size_t)m * 64 + lane] = f2bf(o1); kr[(size_t)m * 64 + 32 + lane] = f2bf(o2);
            } }
    }
}

__device__ __forceinline__ void conv8(const bf16_t* xbc, const float* cw, const float* cb, int t, int ch, float (&o)[8]) {
    u32x4 u[4]; f32x4 w0[4], w1[4];
#pragma unroll
    for (int k = 0; k < 4; ++k) { const int tt = t - 3 + k, tc = tt < 0 ? 0 : tt;
        u[k] = *(const u32x4*)(xbc + (size_t)tc * XBCW + ch); w0[k] = *(const f32x4*)(cw + k * XBCW + ch); w1[k] = *(const f32x4*)(cw + k * XBCW + ch + 4); }
    { const f32x4 b0 = *(const f32x4*)(cb + ch), b1 = *(const f32x4*)(cb + ch + 4); o[0] = b0.x; o[1] = b0.y; o[2] = b0.z; o[3] = b0.w; o[4] = b1.x; o[5] = b1.y; o[6] = b1.z; o[7] = b1.w; }
#pragma unroll
    for (int k = 0; k < 4; ++k) { const float mk = (t - 3 + k >= 0) ? 1.f : 0.f; const f32x4 a = w0[k] * mk, b = w1[k] * mk;
        o[0] += a.x * bf_lo(u[k].x); o[1] += a.y * bf_hi(u[k].x); o[2] += a.z * bf_lo(u[k].y); o[3] += a.w * bf_hi(u[k].y);
        o[4] += b.x * bf_lo(u[k].z); o[5] += b.y * bf_hi(u[k].z); o[6] += b.z * bf_lo(u[k].w); o[7] += b.w * bf_hi(u[k].w); }
#pragma unroll
    for (int i = 0; i < 8; ++i) o[i] = silu(o[i]);
}
struct ConvW { f32x4 w0[4], w1[4], b0, b1; };
__device__ __forceinline__ void convw_load(ConvW& W, const float* cw, const float* cb, int ch) {
#pragma unroll
    for (int k = 0; k < 4; ++k) { W.w0[k] = *(const f32x4*)(cw + k * XBCW + ch); W.w1[k] = *(const f32x4*)(cw + k * XBCW + ch + 4); }
    W.b0 = *(const f32x4*)(cb + ch); W.b1 = *(const f32x4*)(cb + ch + 4);
}
template <int NR> __device__ __forceinline__ void conv_rows_load(const bf16_t* xbc, int t0, int ch, u32x4 (&u)[NR + 3]) {
#pragma unroll
    for (int i = 0; i < NR + 3; ++i) { const int tt = t0 - 3 + i, tc = tt < 0 ? 0 : tt; const u32x4 v = *(const u32x4*)(xbc + (size_t)tc * XBCW + ch); u[i] = (tt >= 0) ? v : (u32x4){0u, 0u, 0u, 0u}; }
}
template <int NR> __device__ __forceinline__ void conv_row_out(const ConvW& W, const u32x4 (&u)[NR + 3], int r, float (&o)[8]) {
    o[0] = W.b0.x; o[1] = W.b0.y; o[2] = W.b0.z; o[3] = W.b0.w; o[4] = W.b1.x; o[5] = W.b1.y; o[6] = W.b1.z; o[7] = W.b1.w;
#pragma unroll
    for (int k = 0; k < 4; ++k) { const u32x4 v = u[r + k]; const f32x4 a = W.w0[k], b = W.w1[k];
        o[0] += a.x * bf_lo(v.x); o[1] += a.y * bf_hi(v.x); o[2] += a.z * bf_lo(v.y); o[3] += a.w * bf_hi(v.y);
        o[4] += b.x * bf_lo(v.z); o[5] += b.y * bf_hi(v.z); o[6] += b.z * bf_lo(v.w); o[7] += b.w * bf_hi(v.w); }
#pragma unroll
    for (int i = 0; i < 8; ++i) o[i] = silu(o[i]);
}
__device__ __forceinline__ int pi32(int m) { const int a = m >> 3, h = (m >> 2) & 1, b = m & 3; return 16 * (a >> 1) + 8 * h + 4 * (a & 1) + b; }
__device__ __forceinline__ int crow(int r, int hi) { return (r & 3) + 8 * (r >> 2) + 4 * hi; }

constexpr int SP = 272;
__device__ __forceinline__ float chunk_scan(const float* dtg, int r0, int valid, int h, float ah, float* acum, float* dtv, int lane) {
    const int s0 = 2 * lane, s1 = 2 * lane + 1;
    const float d0 = (s0 < valid) ? dtg[(size_t)(r0 + s0) * 16 + h] : 0.f, d1 = (s1 < valid) ? dtg[(size_t)(r0 + s1) * 16 + h] : 0.f;
    const float a0 = d0 * ah, a1 = d1 * ah, c = a0 + a1; float incl = c;
#pragma unroll
    for (int o = 1; o < 64; o <<= 1) { const float t = __shfl_up(incl, o); if (lane >= o) incl += t; }
    const float excl = incl - c;
    acum[s0] = excl + a0; acum[s1] = incl; dtv[s0] = d0; dtv[s1] = d1;
    return __shfl(incl, 63);
}

__device__ __forceinline__ void phase_ssd_states(const Params& P, unsigned char* lds, int tid, int wave, int lane) {
    const bf16_t* xbc = (const bf16_t*)(P.ws + WS_XBC); const float* dtg = (const float*)(P.ws + WS_DT);
    bf16_t* st = (bf16_t*)(P.ws + WS_ST); float* cdec = (float*)(P.ws + WS_CDEC); bf16_t* bconv = (bf16_t*)(P.ws + WS_BCONV); bf16_t* mixx = (bf16_t*)(P.ws + WS_MIX);
    unsigned char* Bt = lds;
    unsigned char* XT = lds + 128 * SP + wave * (32 * SP);
    float* acum = (float*)(lds + 128 * SP + 8 * 32 * SP) + wave * 256; float* wts = acum + 128;
    const int r32 = lane & 31, hi = lane >> 5;
    for (int item = blockIdx.x; item < NCH * 2; item += gridDim.x) {
        const int c = item >> 1, g = item & 1; const int r0 = (c == 0) ? 0 : NMETA + 128 * (c - 1), valid = (c == 0) ? NMETA : 128;
        __syncthreads();
        {
            const int n8 = (tid & 15) * 8, s0 = (tid >> 4) * 4, chB = 1024 + g * 128 + n8;
            if (s0 < valid) {
                ConvW W; convw_load(W, P.conv_w, P.conv_b, chB); u32x4 u[7]; conv_rows_load<4>(xbc, r0 + s0, chB, u);
#pragma unroll
                for (int rp = 0; rp < 2; ++rp) { float oa[8], ob[8]; conv_row_out<4>(W, u, 2 * rp, oa); conv_row_out<4>(W, u, 2 * rp + 1, ob);
                    const int sa = s0 + 2 * rp;
                    { u32x4 w; w.x = pk2(oa[0], oa[1]); w.y = pk2(oa[2], oa[3]); w.z = pk2(oa[4], oa[5]); w.w = pk2(oa[6], oa[7]); *(u32x4*)(bconv + (size_t)(r0 + sa) * 256 + g * 128 + n8) = w; }
                    { u32x4 w; w.x = pk2(ob[0], ob[1]); w.y = pk2(ob[2], ob[3]); w.z = pk2(ob[4], ob[5]); w.w = pk2(ob[6], ob[7]); *(u32x4*)(bconv + (size_t)(r0 + sa + 1) * 256 + g * 128 + n8) = w; }
#pragma unroll
                    for (int i = 0; i < 8; ++i) *(unsigned*)(Bt + (n8 + i) * SP + sa * 2) = pk2(oa[i], ob[i]); }
            } else {
#pragma unroll
                for (int rp = 0; rp < 2; ++rp)
#pragma unroll
                    for (int i = 0; i < 8; ++i) *(unsigned*)(Bt + (n8 + i) * SP + (s0 + 2 * rp) * 2) = 0u; }
        }
        const int h = g * 8 + wave; const float ah = -__expf(P.a_log[h]);
        const float total = chunk_scan(dtg, r0, valid, h, ah, acum, wts + 0, lane);
        { const int s0 = 2 * lane; const float w0 = __expf(total - acum[s0]) * wts[s0], w1 = __expf(total - acum[s0 + 1]) * wts[s0 + 1]; wts[s0] = w0; wts[s0 + 1] = w1; }
        if (lane == 0) cdec[c * 16 + h] = __expf(total);
        __syncthreads();
        for (int ph = 0; ph < 2; ++ph) {
            {
                const int p8 = (lane & 3) * 8, s0 = (lane >> 2) * 8, chX = h * 64 + ph * 32 + p8;
                if (s0 < valid) {
                    ConvW W; convw_load(W, P.conv_w, P.conv_b, chX); u32x4 u[11]; conv_rows_load<8>(xbc, r0 + s0, chX, u);
#pragma unroll
                    for (int rp = 0; rp < 4; ++rp) { float oa[8], ob[8]; conv_row_out<8>(W, u, 2 * rp, oa); conv_row_out<8>(W, u, 2 * rp + 1, ob);
                        const int sa = s0 + 2 * rp; const float wa = wts[sa], wb2 = wts[sa + 1];
                        { u32x4 wv; wv.x = pk2(oa[0], oa[1]); wv.y = pk2(oa[2], oa[3]); wv.z = pk2(oa[4], oa[5]); wv.w = pk2(oa[6], oa[7]); *(u32x4*)(mixx + (size_t)(r0 + sa) * 2048 + 1024 + chX) = wv; }
                        { u32x4 wv; wv.x = pk2(ob[0], ob[1]); wv.y = pk2(ob[2], ob[3]); wv.z = pk2(ob[4], ob[5]); wv.w = pk2(ob[6], ob[7]); *(u32x4*)(mixx + (size_t)(r0 + sa + 1) * 2048 + 1024 + chX) = wv; }
#pragma unroll
                        for (int i = 0; i < 8; ++i) *(unsigned*)(XT + (p8 + i) * SP + sa * 2) = pk2(oa[i] * wa, ob[i] * wb2); }
                } else {
#pragma unroll
                    for (int rp = 0; rp < 4; ++rp)
#pragma unroll
                        for (int i = 0; i < 8; ++i) *(unsigned*)(XT + (p8 + i) * SP + (s0 + 2 * rp) * 2) = 0u; }
            }
            __builtin_amdgcn_s_waitcnt(0); asm volatile("" ::: "memory");
            if (c == NCH - 1) continue;
            f32x16 acc[4];
#pragma unroll
            for (int nb = 0; nb < 4; ++nb) acc[nb] = f32x16{};
            const int nks = (valid + 15) >> 4;
            for (int ks = 0; ks < nks; ++ks) { const bf16x8 xf = *(const bf16x8*)(XT + r32 * SP + (16 * ks + 8 * hi) * 2);
#pragma unroll
                for (int nb = 0; nb < 4; ++nb) { const bf16x8 bfr = *(const bf16x8*)(Bt + (32 * nb + r32) * SP + (16 * ks + 8 * hi) * 2);
                    acc[nb] = __builtin_amdgcn_mfma_f32_32x32x16_bf16(bfr, xf, acc[nb], 0, 0, 0); } }
#pragma unroll
            for (int nb = 0; nb < 4; ++nb)
#pragma unroll
                for (int rg = 0; rg < 4; ++rg) { u32x2 w; w.x = pk2(acc[nb][4 * rg], acc[nb][4 * rg + 1]); w.y = pk2(acc[nb][4 * rg + 2], acc[nb][4 * rg + 3]);
                    *(u32x2*)(XT + r32 * SP + (32 * nb + 8 * rg + 4 * hi) * 2) = w; }
            __builtin_amdgcn_s_waitcnt(0); asm volatile("" ::: "memory");
            bf16_t* so = st + ((size_t)c * 16 + h) * 8192 + (size_t)(ph * 32) * 128;
#pragma unroll
            for (int it = 0; it < 8; ++it) { const int p = it * 4 + (lane >> 4), ch = lane & 15;
                *(u32x4*)(so + p * 128 + ch * 8) = *(const u32x4*)(XT + p * SP + ch * 16); }
            __builtin_amdgcn_s_waitcnt(0); asm volatile("" ::: "memory");
        }
    }
    __syncthreads();
}

__device__ __forceinline__ void phase_scan(const Params& P, int tid) {
    unsigned* st = (unsigned*)(P.ws + WS_ST); const float* cdec = (const float*)(P.ws + WS_CDEC);
    if (tid < 256) {
        for (int e0 = blockIdx.x * 512; e0 < 131072; e0 += gridDim.x * 512) {
            const int h = __builtin_amdgcn_readfirstlane(e0 >> 13);
            unsigned* pe = st + ((e0 >> 1) + tid);
            float h0 = 0.f, h1 = 0.f;
#pragma nounroll
            for (int seg = 0; seg < 3; ++seg) {
                unsigned v[43]; unsigned* ps = pe + (size_t)(43 * seg) * 65536; const float* dcp = cdec + (43 * seg) * 16 + h;
#pragma unroll
                for (int c = 0; c < 43; ++c) v[c] = ps[(size_t)c * 65536];
#pragma unroll
                for (int c = 0; c < 43; ++c) { const float dc = dcp[c * 16]; ps[(size_t)c * 65536] = pk2(h0, h1); h0 = dc * h0 + bf_lo(v[c]); h1 = dc * h1 + bf_hi(v[c]); }
            }
        }
    }
}

__device__ __forceinline__ void phase_ssd_y(const Params& P, unsigned char* lds, int tid, int wave, int lane) {
    const bf16_t* xbc = (const bf16_t*)(P.ws + WS_XBC); const float* dtg = (const float*)(P.ws + WS_DT); const bf16_t* zb = (const bf16_t*)(P.ws + WS_Z);
    const bf16_t* st = (const bf16_t*)(P.ws + WS_ST); bf16_t* mix = (bf16_t*)(P.ws + WS_MIX); const bf16_t* bconv = (const bf16_t*)(P.ws + WS_BCONV);
    unsigned char* Bs = lds; unsigned char* Cs = lds + 128 * SP;
    unsigned char* XT = lds + 2 * 128 * SP + wave * (32 * SP);
    unsigned char* YS = XT;
    float* acum = (float*)(lds + 2 * 128 * SP + 8 * 32 * SP) + wave * 384; float* dtv = acum + 128; float* gtab = acum + 256;
    float* rowss = (float*)(lds + 2 * 128 * SP + 8 * 32 * SP + 8 * 1536);
    static_assert(2 * 128 * SP + 8 * 32 * SP + 8 * 1536 + 8192 <= LDS_BYTES - 64, "ssd_y LDS");
    const int r32 = lane & 31, hi = lane >> 5;
    for (int item = blockIdx.x; item < NCH * 2; item += gridDim.x) {
        const int c = item >> 1, g = item & 1; const int r0 = (c == 0) ? 0 : NMETA + 128 * (c - 1), valid = (c == 0) ? NMETA : 128;
        if (c == 0) continue;
        __syncthreads();
        for (int ck = tid; ck < 4096; ck += 512) { const int isC = ck >> 11, c2 = ck & 2047, s = c2 >> 4, n8 = (c2 & 15) * 8; float o[8];
            u32x4 w = {0u, 0u, 0u, 0u};
            if (s < valid) { if (isC) { conv8(xbc, P.conv_w, P.conv_b, r0 + s, 1280 + g * 128 + n8, o); w.x = pk2(o[0], o[1]); w.y = pk2(o[2], o[3]); w.z = pk2(o[4], o[5]); w.w = pk2(o[6], o[7]); }
                             else w = *(const u32x4*)(bconv + (size_t)(r0 + s) * 256 + g * 128 + n8); }
            *(u32x4*)((isC ? Cs : Bs) + s * SP + n8 * 2) = w; }
        const int h = g * 8 + wave; const float ah = -__expf(P.a_log[h]); const float dsk = P.d_skip[h];
        (void)chunk_scan(dtg, r0, valid, h, ah, acum, dtv, lane);
        { const int s0 = 2 * lane; const float R = acum[(s0 & ~31) + 31]; gtab[s0] = __expf(R - acum[s0]) * dtv[s0]; gtab[s0 + 1] = __expf(R - acum[s0 + 1]) * dtv[s0 + 1]; }
        __syncthreads();
        for (int ph = 0; ph < 2; ++ph) {
            for (int ck = lane; ck < 512; ck += 64) { const int s = ck >> 2, p8 = (ck & 3) * 8; float o[8];
                u32x4 xv = {0u, 0u, 0u, 0u};
                if (s < valid) xv = *(const u32x4*)(mix + (size_t)(r0 + s) * 2048 + 1024 + h * 64 + ph * 32 + p8);
                (void)o;
#pragma unroll
                for (int i = 0; i < 4; ++i) { *(bf16_t*)(XT + (p8 + 2 * i) * SP + s * 2) = (bf16_t)(xv[i] & 0xffffu); *(bf16_t*)(XT + (p8 + 2 * i + 1) * SP + s * 2) = (bf16_t)(xv[i] >> 16); } }
            bf16x8 pvf[8];
            { const bf16_t* pv = st + ((size_t)c * 16 + h) * 8192 + (size_t)(ph * 32 + r32) * 128 + 8 * hi;
#pragma unroll
              for (int ks = 0; ks < 8; ++ks) pvf[ks] = *(const bf16x8*)(pv + 16 * ks); }
            __builtin_amdgcn_s_waitcnt(0); asm volatile("" ::: "memory");
            const int nlb = (valid + 31) >> 5;
            u32x2 yp[4][4];
#pragma unroll
            for (int q4 = 0; q4 < 4; ++q4)
#pragma unroll
                for (int rg = 0; rg < 4; ++rg) yp[q4][rg] = (u32x2){0u, 0u};
            for (int lb = 0; lb < nlb; ++lb) {
                const int l = 32 * lb + r32;
                bf16x8 cf[8];
#pragma unroll
                for (int ks = 0; ks < 8; ++ks) cf[ks] = *(const bf16x8*)(Cs + l * SP + (16 * ks + 8 * hi) * 2);
                f32x16 accd = f32x16{}, acco = f32x16{};
#pragma unroll
                for (int ks = 0; ks < 8; ++ks) acco = __builtin_amdgcn_mfma_f32_32x32x16_bf16(pvf[ks], cf[ks], acco, 0, 0, 0);
                const float al = acum[l];
                for (int sb = 0; sb <= lb; ++sb) {
                    f32x16 sT = f32x16{};
                    const unsigned char* brow = Bs + (32 * sb + pi32(r32)) * SP + 16 * hi;
                    { bf16x8 bb[2]; bb[0] = *(const bf16x8*)(brow); bb[1] = *(const bf16x8*)(brow + 32);
#pragma unroll
                      for (int ks = 0; ks < 8; ++ks) { sT = __builtin_amdgcn_mfma_f32_32x32x16_bf16(bb[ks & 1], cf[ks], sT, 0, 0, 0); if (ks + 2 < 8) bb[ks & 1] = *(const bf16x8*)(brow + 32 * (ks + 2)); } }
                    unsigned wb[8];
                    if (sb < lb) {
                        const float fl = __expf(al - acum[32 * sb + 31]);
#pragma unroll
                        for (int hf = 0; hf < 2; ++hf) {
                            const int sb0 = 32 * sb + 16 * hf + 8 * hi;
                            const f32x4 d0 = *(const f32x4*)(gtab + sb0), d1 = *(const f32x4*)(gtab + sb0 + 4);
#pragma unroll
                            for (int j = 0; j < 4; ++j) { const float ga = (j < 2) ? d0[2 * j] : d1[2 * j - 4], gb = (j < 2) ? d0[2 * j + 1] : d1[2 * j - 3];
                                wb[4 * hf + j] = pk2(sT[8 * hf + 2 * j] * (fl * ga), sT[8 * hf + 2 * j + 1] * (fl * gb)); } }
                    } else {
#pragma unroll
                        for (int hf = 0; hf < 2; ++hf) {
                            const int sb0 = 32 * sb + 16 * hf + 8 * hi;
                            const f32x4 a0 = *(const f32x4*)(acum + sb0), a1 = *(const f32x4*)(acum + sb0 + 4), d0 = *(const f32x4*)(dtv + sb0), d1 = *(const f32x4*)(dtv + sb0 + 4);
                            float wv[8];
#pragma unroll
                            for (int j = 0; j < 8; ++j) { const float aj = (j < 4) ? a0[j & 3] : a1[j & 3], dj = (j < 4) ? d0[j & 3] : d1[j & 3]; const int sj = sb0 + j;
                                const float e = __expf(fminf(al - aj, 0.f)) * dj; float v = sT[8 * hf + j] * e; v = (sj <= l) ? v : 0.f; v += (sj == l) ? dsk : 0.f; wv[j] = v; }
#pragma unroll
                            for (int j = 0; j < 4; ++j) wb[4 * hf + j] = pk2(wv[2 * j], wv[2 * j + 1]); } }
                    const u32x4 w0 = {wb[0], wb[1], wb[2], wb[3]}, w1 = {wb[4], wb[5], wb[6], wb[7]};
                    const bf16x8 x0 = *(const bf16x8*)(XT + r32 * SP + (32 * sb + 8 * hi) * 2), x1 = *(const bf16x8*)(XT + r32 * SP + (32 * sb + 16 + 8 * hi) * 2);
                    accd = __builtin_amdgcn_mfma_f32_32x32x16_bf16(x0, __builtin_bit_cast(bf16x8, w0), accd, 0, 0, 0);
                    accd = __builtin_amdgcn_mfma_f32_32x32x16_bf16(x1, __builtin_bit_cast(bf16x8, w1), accd, 0, 0, 0);
                }
                { const float el = __expf(al);
#pragma unroll
                  for (int rg = 0; rg < 4; ++rg) { u32x2 w; w.x = pk2(accd[4 * rg] + el * acco[4 * rg], accd[4 * rg + 1] + el * acco[4 * rg + 1]); w.y = pk2(accd[4 * rg + 2] + el * acco[4 * rg + 2], accd[4 * rg + 3] + el * acco[4 * rg + 3]);
#pragma unroll
                      for (int q4 = 0; q4 < 4; ++q4) if (q4 == lb) yp[q4][rg] = w; } }
            }
#pragma unroll
            for (int q4 = 0; q4 < 4; ++q4) if (q4 < nlb) {
#pragma unroll
                for (int rg = 0; rg < 4; ++rg) *(u32x2*)(YS + (32 * q4 + r32) * 64 + (8 * rg + 4 * hi) * 2) = yp[q4][rg]; }
            __builtin_amdgcn_s_waitcnt(0); asm volatile("" ::: "memory");
            for (int it = 0; it < 2 * nlb; ++it) { const int l = it * 16 + (lane >> 2), c8 = (lane & 3) * 8; const size_t row = (size_t)(r0 + l);
                const u32x4 yb = *(const u32x4*)(YS + l * 64 + c8 * 2); u32x4 zz = {0u, 0u, 0u, 0u};
                if (l < valid) zz = *(const u32x4*)(zb + row * 1024 + h * 64 + ph * 32 + c8);
                float gq[8]; float ss = 0.f;
#pragma unroll
                for (int j = 0; j < 4; ++j) { gq[2 * j] = bf_lo(yb[j]) * silu(bf_lo(zz[j])); gq[2 * j + 1] = bf_hi(yb[j]) * silu(bf_hi(zz[j])); ss += gq[2 * j] * gq[2 * j] + gq[2 * j + 1] * gq[2 * j + 1]; }
                ss += __shfl_xor(ss, 1); ss += __shfl_xor(ss, 2);
                if ((lane & 3) == 0) rowss[(wave * 2 + ph) * 128 + l] = ss;
                if (l < valid) { u32x4 w; w.x = pk2(gq[0], gq[1]); w.y = pk2(gq[2], gq[3]); w.z = pk2(gq[4], gq[5]); w.w = pk2(gq[6], gq[7]); *(u32x4*)(mix + row * 2048 + 1024 + h * 64 + ph * 32 + c8) = w; } }
            __builtin_amdgcn_s_waitcnt(0); asm volatile("" ::: "memory");
        }
        __syncthreads();
        { const int l = tid >> 2, qd = tid & 3;
          if (l < valid) { float ss = 0.f;
#pragma unroll
              for (int k = 0; k < 16; ++k) ss += rowss[k * 128 + l];
              const float rstd = rsqrtf(ss * (1.f / 512.f) + EPS);
              bf16_t* rp = mix + (size_t)(r0 + l) * 2048 + 1024 + g * 512 + qd * 128; const float* gp = P.g_ssm + g * 512 + qd * 128;
#pragma unroll 4
              for (int k = 0; k < 16; ++k) { const u32x4 u = *(const u32x4*)(rp + 8 * k); const f32x4 g0 = *(const f32x4*)(gp + 8 * k), g1 = *(const f32x4*)(gp + 8 * k + 4);
                  u32x4 w; w.x = pk2(bf_lo(u.x) * rstd * g0.x, bf_hi(u.x) * rstd * g0.y); w.y = pk2(bf_lo(u.y) * rstd * g0.z, bf_hi(u.y) * rstd * g0.w);
                  w.z = pk2(bf_lo(u.z) * rstd * g1.x, bf_hi(u.z) * rstd * g1.y); w.w = pk2(bf_lo(u.w) * rstd * g1.z, bf_hi(u.w) * rstd * g1.w);
                  *(u32x4*)(rp + 8 * k) = w; } } }
    }
    __syncthreads();
}

namespace att {
constexpr int KP = 400, VP = 144, KT_BYTES = 64 * KP, VT_BYTES = 128 * VP, STG = KT_BYTES + VT_BYTES;
struct Stage { u32x4 k0, k1, kr, v0, v1; };
__device__ __forceinline__ void gload(Stage& s, const bf16_t* kb, const bf16_t* krb, const bf16_t* vt, int h, int kbase, int tid) {
    s.k0 = *(const u32x4*)(kb + (size_t)(kbase + (tid >> 4)) * 1024 + h * 128 + (tid & 15) * 8);
    s.k1 = *(const u32x4*)(kb + (size_t)(kbase + 32 + (tid >> 4)) * 1024 + h * 128 + (tid & 15) * 8);
    s.kr = *(const u32x4*)(krb + (size_t)(kbase + (tid >> 3)) * 64 + (tid & 7) * 8);
    s.v0 = *(const u32x4*)(vt + (size_t)(h * 128 + (tid >> 3)) * MP + kbase + (tid & 7) * 8);
    s.v1 = *(const u32x4*)(vt + (size_t)(h * 128 + 64 + (tid >> 3)) * MP + kbase + (tid & 7) * 8);
}
__device__ __forceinline__ void sstore(const Stage& s, unsigned char* buf, int tid) {
    unsigned char* Kt = buf; unsigned char* Vt = buf + KT_BYTES;
    *(u32x4*)(Kt + (tid >> 4) * KP + (tid & 15) * 16) = s.k0;
    *(u32x4*)(Kt + (32 + (tid >> 4)) * KP + (tid & 15) * 16) = s.k1;
    *(u32x4*)(Kt + (tid >> 3) * KP + 256 + (tid & 7) * 16) = s.kr;
    *(u32x4*)(Vt + (tid >> 3) * VP + (tid & 7) * 16) = s.v0;
    *(u32x4*)(Vt + (64 + (tid >> 3)) * VP + (tid & 7) * 16) = s.v1;
}
constexpr int VSLOT0 = 2 * KT_BYTES;
__device__ __forceinline__ void glds16(const void* gsrc, unsigned lds_dst) { unsigned keep;
    asm volatile("s_mov_b32 %0, m0\n\ts_mov_b32 m0, %2\n\ts_nop 0\n\tglobal_load_lds_dwordx4 %1, off\n\ts_mov_b32 m0, %0" : "=&s"(keep) : "v"(gsrc), "s"(lds_dst) : "memory"); }
constexpr float THR = 8.f;
__device__ __forceinline__ float max3f(float a, float b, float c) { float r; asm("v_max3_f32 %0, %1, %2, %3" : "=v"(r) : "v"(a), "v"(b), "v"(c)); return r; }
__device__ __forceinline__ float max2f(float a, float b) { float r; asm("v_max_f32_e32 %0, %1, %2" : "=v"(r) : "v"(a), "v"(b)); return r; }
__device__ __forceinline__ float xhalf_max(float m) { auto rr = __builtin_amdgcn_permlane32_swap(__float_as_uint(m), __float_as_uint(m), false, false); return max2f(__uint_as_float(rr[0]), __uint_as_float(rr[1])); }
#define ATT_SB() __builtin_amdgcn_sched_barrier(0)
__device__ __forceinline__ void unit(const Params& P, unsigned char* lds, int h, int q0, int NT, int slo, int shi, int tid, int wave, int lane) {
    const bf16_t* qb = (const bf16_t*)(P.ws + WS_Q); const bf16_t* kb = (const bf16_t*)(P.ws + WS_K); const bf16_t* krb = (const bf16_t*)(P.ws + WS_KR);
    const bf16_t* vt = (const bf16_t*)(P.ws + WS_VT); bf16_t* mix = (bf16_t*)(P.ws + WS_MIX); const float2* rope = (const float2*)(P.ws + WS_ROPE);
    const int r32 = lane & 31, hi = lane >> 5;
    const int qrow = q0 + 32 * wave + r32;
    const unsigned lds0 = (unsigned)(uintptr_t)lds;
    unsigned koff[4], voff[3];
#pragma unroll
    for (int j = 0; j < 4; ++j) { const int i = 64 * (wave + 8 * j) + lane, row = i / 25, col = i - 25 * row;
        if (col >= 16 && col < 24) koff[j] = ((unsigned)WS_KR + (unsigned)((row * 64 + (col - 16) * 8) * 2)) | 1u;
        else koff[j] = (unsigned)WS_K + (unsigned)((row * 1024 + h * 128 + (col < 16 ? col : 0) * 8) * 2); }
#pragma unroll
    for (int j = 0; j < 3; ++j) { const int i = 64 * (wave + 8 * j) + lane, d = i / 9, c = i - 9 * d; voff[j] = (unsigned)WS_VT + (unsigned)(((h * 128 + d) * MP + (c < 8 ? c : 0) * 8) * 2); }
#define ATT_ISSUE(t, kslot, vslot) do { const unsigned t_ = (unsigned)(t); \
        _Pragma("unroll") for (int j = 0; j < 4; ++j) if (wave + 8 * j < 25) glds16(P.ws + ((koff[j] & ~1u) + t_ * ((koff[j] & 1u) ? 64u * 128u : 64u * 2048u)), (unsigned)__builtin_amdgcn_readfirstlane(lds0 + (kslot) * KT_BYTES + (wave + 8 * j) * 1024)); \
        _Pragma("unroll") for (int j = 0; j < 3; ++j) if (wave + 8 * j < 18) glds16(P.ws + (voff[j] + t_ * 128u), (unsigned)__builtin_amdgcn_readfirstlane(lds0 + VSLOT0 + (vslot) * VT_BYTES + (wave + 8 * j) * 1024)); } while (0)
#define ATT_ISSUE1(slot, t, kslot, vslot) do { const unsigned t_ = (unsigned)(t); \
        if ((slot) < 4) { if (wave + 8 * (slot) < 25) glds16(P.ws + ((koff[(slot) & 3] & ~1u) + t_ * ((koff[(slot) & 3] & 1u) ? 64u * 128u : 64u * 2048u)), (unsigned)__builtin_amdgcn_readfirstlane(lds0 + (kslot) * KT_BYTES + (wave + 8 * (slot)) * 1024)); } \
        else { if (wave + 8 * ((slot) - 4) < 18) glds16(P.ws + (voff[((slot) - 4) % 3] + t_ * 128u), (unsigned)__builtin_amdgcn_readfirstlane(lds0 + VSLOT0 + (vslot) * VT_BYTES + (wave + 8 * ((slot) - 4)) * 1024)); } } while (0)
    ATT_ISSUE(0, 0, 0);
    bf16x8 qf[12];
    { const bf16_t* qp = qb + (size_t)qrow * QW + h * 192 + 8 * hi;
#pragma unroll
      for (int ks = 0; ks < 12; ++ks) qf[ks] = *(const bf16x8*)(qp + 16 * ks);
#pragma unroll
      for (int kk = 0; kk < 2; ++kk) { u32x4 a = __builtin_bit_cast(u32x4, qf[8 + kk]), b = __builtin_bit_cast(u32x4, qf[10 + kk]); u32x4 oa, ob;
          const float2* cs = rope + (size_t)qrow * 32 + 16 * kk + 8 * hi;
#pragma unroll
          for (int j = 0; j < 4; ++j) { const float2 c0 = cs[2 * j], c1 = cs[2 * j + 1];
              const float x1a = bf_lo(a[j]), x1b = bf_hi(a[j]), x2a = bf_lo(b[j]), x2b = bf_hi(b[j]);
              oa[j] = pk2(x1a * c0.x - x2a * c0.y, x1b * c1.x - x2b * c1.y); ob[j] = pk2(x2a * c0.x + x1a * c0.y, x2b * c1.x + x1b * c1.y); }
          qf[8 + kk] = __builtin_bit_cast(bf16x8, oa); qf[10 + kk] = __builtin_bit_cast(bf16x8, ob); } }
    f32x16 o[4];
#pragma unroll
    for (int d = 0; d < 4; ++d) o[d] = f32x16{};
    float mref = 0.f, lsum = 0.f;
    asm volatile("s_waitcnt vmcnt(0)" ::: "memory");
    __syncthreads();
    const int qmin_w = q0 + 32 * wave, qmax_w = qmin_w + 31;
    const int krow_off = pi32(r32) * KP + 16 * hi;
    f32x16 sA = f32x16{}, sB = f32x16{};
    u32x4 onesf = {hi == 0 ? 0x00003F80u : 0u, 0u, 0u, 0u}, mshf = {0u, 0u, 0u, 0u};
    auto bfround = [](float v) { return __uint_as_float(pk2(v, 0.f) << 16); };
    u32x4 pw0 = {0u, 0u, 0u, 0u}, pw1 = {0u, 0u, 0u, 0u};
#define ATT_FIN4(PC, B) do { lsum += (PC[B] + PC[B + 1]) + (PC[B + 2] + PC[B + 3]); } while (0)
#define ATT_PV(HP) do { const unsigned char* Vh = lds + VSLOT0 + ((((HP) >> 1) % 3) * VT_BYTES) + r32 * VP + (32 * ((HP) & 1) + 8 * hi) * 2; \
        _Pragma("unroll") for (int d = 0; d < 4; ++d) { const bf16x8 v0 = *(const bf16x8*)(Vh + 32 * d * VP), v1 = *(const bf16x8*)(Vh + 32 * d * VP + 32); \
            o[d] = __builtin_amdgcn_mfma_f32_32x32x16_bf16(v0, __builtin_bit_cast(bf16x8, pw0), o[d], 0, 0, 0); o[d] = __builtin_amdgcn_mfma_f32_32x32x16_bf16(v1, __builtin_bit_cast(bf16x8, pw1), o[d], 0, 0, 0); } } while (0)
#define ATT_QKCHAIN(SN, kp_, DMAON, tn_, ksl_, vsl_) do { \
        { const f32x16 z16_ = {0.f, 0.f, 0.f, 0.f, 0.f, 0.f, 0.f, 0.f, 0.f, 0.f, 0.f, 0.f, 0.f, 0.f, 0.f, 0.f}; SN = z16_; } \
        bf16x8 ka_[2]; ka_[0] = *(const bf16x8*)(kp_); ka_[1] = *(const bf16x8*)(kp_ + 32); \
        _Pragma("unroll") for (int ks = 0; ks < 12; ++ks) { \
            SN = __builtin_amdgcn_mfma_f32_32x32x16_bf16(ka_[ks & 1], qf[ks], SN, 0, 0, 0); \
            if (ks + 2 < 12) ka_[ks & 1] = *(const bf16x8*)(kp_ + 32 * (ks + 2)); \
            if ((DMAON) == 1) { if (ks == 2) ATT_ISSUE1(0, tn_, ksl_, vsl_); else if (ks == 5) ATT_ISSUE1(1, tn_, ksl_, vsl_); else if (ks == 8) ATT_ISSUE1(2, tn_, ksl_, vsl_); else if (ks == 11) ATT_ISSUE1(3, tn_, ksl_, vsl_); } \
            else if ((DMAON) == 2) { if (ks == 2) ATT_ISSUE1(4, tn_, ksl_, vsl_); else if (ks == 5) ATT_ISSUE1(5, tn_, ksl_, vsl_); else if (ks == 8) ATT_ISSUE1(6, tn_, ksl_, vsl_); } } } while (0)
#define ATT_ROWSUM(PC) do { float la_ = 0.f; \
        asm("v_add_f32_e32 %0, %0, %2\n\tv_add_f32_e32 %1, %1, %3\n\tv_add_f32_e32 %0, %0, %4\n\tv_add_f32_e32 %1, %1, %5\n\t" \
            "v_add_f32_e32 %0, %0, %6\n\tv_add_f32_e32 %1, %1, %7\n\tv_add_f32_e32 %0, %0, %8\n\tv_add_f32_e32 %1, %1, %9\n\t" \
            "v_add_f32_e32 %0, %0, %10\n\tv_add_f32_e32 %1, %1, %11\n\tv_add_f32_e32 %0, %0, %12\n\tv_add_f32_e32 %1, %1, %13\n\t" \
            "v_add_f32_e32 %0, %0, %14\n\tv_add_f32_e32 %1, %1, %15\n\tv_add_f32_e32 %0, %0, %16\n\tv_add_f32_e32 %1, %1, %17\n\t" \
            "v_add_f32_e32 %0, %0, %1" \
            : "+v"(lsum), "+v"(la_) : "v"(PC[0]), "v"(PC[1]), "v"(PC[2]), "v"(PC[3]), "v"(PC[4]), "v"(PC[5]), "v"(PC[6]), "v"(PC[7]), \
              "v"(PC[8]), "v"(PC[9]), "v"(PC[10]), "v"(PC[11]), "v"(PC[12]), "v"(PC[13]), "v"(PC[14]), "v"(PC[15])); } while (0)
#define ATT_EXPPACK(PC) do { \
        _Pragma("unroll") for (int r = 0; r < 16; ++r) PC[r] = __builtin_amdgcn_exp2f(PC[r]); \
        ATT_SB();     \
        ATT_ROWSUM(PC); \
        pw0.x = pk2(PC[0], PC[1]); pw0.y = pk2(PC[2], PC[3]); pw0.z = pk2(PC[4], PC[5]); pw0.w = pk2(PC[6], PC[7]); \
        pw1.x = pk2(PC[8], PC[9]); pw1.y = pk2(PC[10], PC[11]); pw1.z = pk2(PC[12], PC[13]); pw1.w = pk2(PC[14], PC[15]); } while (0)
#define ATT_STEP(SN, PC, hh, KtP, FIRST, DMAON, tn_, ksl_, vsl_) do { \
        { \
            const unsigned char* kp_ = (KtP) + 32 * ((hh) & 1) * KP + krow_off; \
              \
            ATT_QKCHAIN(SN, kp_, DMAON, tn_, ksl_, vsl_); \
            if (!(FIRST)) { ATT_EXPPACK(PC); } \
            if (!(FIRST)) SN = __builtin_amdgcn_mfma_f32_32x32x16_bf16(__builtin_bit_cast(bf16x8, onesf), __builtin_bit_cast(bf16x8, mshf), SN, 0, 0, 0);     \
              \
            if (32 * (hh) + 31 > qmin_w) { const int kq_ = qrow - 32 * (hh) - 8 * hi; \
                _Pragma("unroll") for (int r = 0; r < 16; ++r) SN[r] = ((16 * (r >> 3) + (r & 7)) > kq_) ? -1e30f : SN[r]; } \
            float mx_; \
            if (!(FIRST)) { \
                const unsigned char* Vh = lds + VSLOT0 + (((((hh) - 1) >> 1) % 3) * VT_BYTES) + r32 * VP + (32 * (((hh) - 1) & 1) + 8 * hi) * 2; \
                bf16x8 va_[2]; va_[0] = *(const bf16x8*)(Vh); va_[1] = *(const bf16x8*)(Vh + 32); \
                _Pragma("unroll") for (int i = 0; i < 8; ++i) { \
                    o[i >> 1] = __builtin_amdgcn_mfma_f32_32x32x16_bf16(va_[i & 1], __builtin_bit_cast(bf16x8, (i & 1) ? pw1 : pw0), o[i >> 1], 0, 0, 0); \
                    ATT_SB(); \
                    if (i + 2 < 8) va_[i & 1] = *(const bf16x8*)(Vh + 32 * ((i + 2) >> 1) * VP + 32 * ((i + 2) & 1)); \
                    if (i == 0) mx_ = __builtin_fmaxf(SN[0], __builtin_fmaxf(SN[1], SN[2]));   \
                    else if (i < 7) mx_ = max3f(mx_, SN[2 * i + 1], SN[2 * i + 2]); else mx_ = max2f(mx_, SN[15]); \
                    ATT_SB(); } \
            } else { \
                mx_ = __builtin_fmaxf(SN[0], __builtin_fmaxf(SN[1], SN[2])); \
                _Pragma("unroll") for (int i = 1; i < 7; ++i) mx_ = max3f(mx_, SN[2 * i + 1], SN[2 * i + 2]); \
                mx_ = max2f(mx_, SN[15]); } \
            mx_ = xhalf_max(mx_); \
            if (FIRST) { mref = bfround(mx_); mshf.x = (hi == 0) ? (pk2(-mref, 0.f) & 0xffffu) : 0u; _Pragma("unroll") for (int r = 0; r < 16; ++r) SN[r] -= mref; } \
            else if (__any(mx_ > THR)) { const float mn_ = bfround(mref + fmaxf(mx_, 0.f)); const float dl_ = mn_ - mref; mref = mn_; mshf.x = (hi == 0) ? (pk2(-mref, 0.f) & 0xffffu) : 0u; \
                const float f_ = __builtin_amdgcn_exp2f(-dl_); lsum *= f_; \
                _Pragma("unroll") for (int r = 0; r < 16; ++r) SN[r] -= dl_; \
                _Pragma("unroll") for (int d = 0; d < 4; ++d) o[d] = o[d] * f_; } \
            ATT_SB(); \
        } \
    } while (0)
    {
        const bool more0 = 1 < NT;
        ATT_STEP(sA, sB, 0, lds, 1, (more0 ? 1 : 0), 1, 1, 1);
        ATT_STEP(sB, sA, 1, lds, 0, (more0 ? 2 : 0), 1, 1, 1);
        asm volatile("s_waitcnt vmcnt(0)" ::: "memory");
        __syncthreads();
    }
    for (int kt = 1; kt < NT; ++kt) {
        const bool more = kt + 1 < NT; const int ksn = (kt + 1) & 1, vsn = (kt + 1) % 3;
        const unsigned char* Kt = lds + (kt & 1) * KT_BYTES;
        ATT_STEP(sA, sB, 2 * kt, Kt, 0, (more ? 1 : 0), kt + 1, ksn, vsn);
        ATT_STEP(sB, sA, 2 * kt + 1, Kt, 0, (more ? 2 : 0), kt + 1, ksn, vsn);
        asm volatile("s_waitcnt vmcnt(0)" ::: "memory");
        __syncthreads();
    }
    {
#pragma unroll
        for (int r = 0; r < 16; ++r) sB[r] = __builtin_amdgcn_exp2f(sB[r]);
        pw0.x = pk2(sB[0], sB[1]); pw0.y = pk2(sB[2], sB[3]); pw0.z = pk2(sB[4], sB[5]); pw0.w = pk2(sB[6], sB[7]);
        pw1.x = pk2(sB[8], sB[9]); pw1.y = pk2(sB[10], sB[11]); pw1.z = pk2(sB[12], sB[13]); pw1.w = pk2(sB[14], sB[15]);
        ATT_SB();
        ATT_ROWSUM(sB);
        ATT_PV(2 * NT - 1);
        __syncthreads();
    }
#undef ATT_ISSUE
#undef ATT_ISSUE1
#undef ATT_STEP
#undef ATT_QKCHAIN
#undef ATT_EXPPACK
#undef ATT_ROWSUM
#undef ATT_PV
#undef ATT_FIN4
    lsum += __shfl_xor(lsum, 32);
    const float inv = 1.f / lsum;
    if (qrow >= slo && qrow < shi) {
        bf16_t* op = mix + (size_t)qrow * 2048 + h * 128 + 4 * hi;
#pragma unroll
        for (int d = 0; d < 4; ++d)
#pragma unroll
            for (int rg = 0; rg < 4; ++rg) { u32x2 w; w.x = pk2(o[d][4 * rg] * inv, o[d][4 * rg + 1] * inv); w.y = pk2(o[d][4 * rg + 2] * inv, o[d][4 * rg + 3] * inv);
                *(u32x2*)(op + 32 * d + 8 * rg) = w; }
    }
}
__device__ __forceinline__ void phase(const Params& P, unsigned char* lds, int tid, int wave, int lane) {
    for (int w = blockIdx.x; w < 256; w += gridDim.x) {
        const int nu = (w < 256) ? 2 : 1;
#pragma nounroll
        for (int u = 0; u < nu; ++u) {
            int h, b; if (w < 256) { h = w & 7; const int j = w >> 3; b = (u == 0) ? 64 - j : j + 1; } else { h = w - 256; b = 0; }
            const int q0 = b ? NMETA + 256 * (b - 1) : 0, NT = b ? 4 * b + 1 : 1, shi = b ? q0 + 256 : NMETA;
            unit(P, lds, h, q0, NT, q0, shi, tid, wave, lane);
        }
    }
}
}

__device__ __forceinline__ void phase_rows1(const Params& P, int gw, int NGW, int lane) {
    const bf16_t* mixo = (const bf16_t*)(P.ws + WS_MIXO); bf16_t* hn2 = (bf16_t*)(P.ws + WS_HN2);
    for (int m = gw; m < SEQ; m += NGW) {
        const u32x2* mr = (const u32x2*)(mixo + (size_t)m * DM) + lane; const f32x4* xr = (const f32x4*)(P.x + (size_t)m * DM) + lane;
        const f32x4* g1 = (const f32x4*)P.g_mix_post + lane; const f32x4* g2 = (const f32x4*)P.g_mlp_pre + lane;
        f32x4 v[4]; float s = 0.f;
#pragma unroll
        for (int j = 0; j < 4; ++j) { const u32x2 u = mr[64 * j]; v[j] = (f32x4){bf_lo(u.x), bf_hi(u.x), bf_lo(u.y), bf_hi(u.y)}; s += (v[j].x * v[j].x + v[j].y * v[j].y) + (v[j].z * v[j].z + v[j].w * v[j].w); }
        const float r1 = rsqrtf(wave_sum(s) * (1.f / DM) + EPS); float s2 = 0.f;
#pragma unroll
        for (int j = 0; j < 4; ++j) { v[j] = xr[64 * j] + v[j] * r1 * g1[64 * j]; s2 += (v[j].x * v[j].x + v[j].y * v[j].y) + (v[j].z * v[j].z + v[j].w * v[j].w); }
        const float r2 = rsqrtf(wave_sum(s2) * (1.f / DM) + EPS);
        f32x4* orow = (f32x4*)(P.out + (size_t)m * DM) + lane; unsigned long long* o8 = (unsigned long long*)(hn2 + (size_t)m * DM) + lane;
#pragma unroll
        for (int j = 0; j < 4; ++j) { orow[64 * j] = v[j]; const f32x4 g = g2[64 * j];
            o8[64 * j] = (unsigned long long)pk2(v[j].x * r2 * g.x, v[j].y * r2 * g.y) | ((unsigned long long)pk2(v[j].z * r2 * g.z, v[j].w * r2 * g.w) << 32); }
    }
}
__device__ __forceinline__ void phase_rows2(const Params& P, int gw, int NGW, int lane) {
    const bf16_t* f = (const bf16_t*)(P.ws + WS_F);
    for (int m = gw; m < SEQ; m += NGW) {
        const u32x2* fr = (const u32x2*)(f + (size_t)m * DM) + lane; f32x4* orow = (f32x4*)(P.out + (size_t)m * DM) + lane; const f32x4* g1 = (const f32x4*)P.g_mlp_post + lane;
        f32x4 v[4]; float s = 0.f;
#pragma unroll
        for (int j = 0; j < 4; ++j) { const u32x2 u = fr[64 * j]; v[j] = (f32x4){bf_lo(u.x), bf_hi(u.x), bf_lo(u.y), bf_hi(u.y)}; s += (v[j].x * v[j].x + v[j].y * v[j].y) + (v[j].z * v[j].z + v[j].w * v[j].w); }
        const float r1 = rsqrtf(wave_sum(s) * (1.f / DM) + EPS);
#pragma unroll
        for (int j = 0; j < 4; ++j) orow[64 * j] = orow[64 * j] + v[j] * r1 * g1[64 * j];
    }
}

#define LAS __attribute__((address_space(3)))
#define XB_TMO      128
#define XB_XCNT(j)  (256  + 64 * (j))
#define XB_XSUB(j)  (1280 + 64 * (j))
#define XB_XGEN(j)  (2304 + 64 * (j))
#define XB_TOP      3328
#define XB_TOPGEN   3392
#define XCD_BAR_WORDS 3456
#define XB_SPIN_CAP (1u << 18)
__device__ __forceinline__ unsigned xb_ld(unsigned* p)              { return __hip_atomic_load(p, __ATOMIC_RELAXED, __HIP_MEMORY_SCOPE_AGENT); }
__device__ __forceinline__ unsigned xb_add(unsigned* p, unsigned v) { return __hip_atomic_fetch_add(p, v, __ATOMIC_RELAXED, __HIP_MEMORY_SCOPE_AGENT); }
__device__ __forceinline__ unsigned xb_xcc_id() { return (unsigned)__builtin_amdgcn_s_getreg((3 << 11) | 20) & 0xFu; }
#define XB_SPIN(cond, bar) do { unsigned _sp = 0; while (cond) { __builtin_amdgcn_s_sleep(1); \
    if ((++_sp & 255u) == 0u) { if (xb_ld(&(bar)[XB_TMO])) break; if (_sp > XB_SPIN_CAP) { atomicAdd(&(bar)[XB_TMO], 1u); break; } } } } while (0)
struct XcdBarrier { unsigned* bar; unsigned x; volatile LAS unsigned* st; };
__device__ __forceinline__ XcdBarrier xcd_barrier_post(unsigned* bar, volatile LAS unsigned* st) {
    XcdBarrier b; b.bar = bar; b.x = xb_xcc_id(); b.st = st;
    if (threadIdx.x == 0) (void)xb_add(&bar[XB_XCNT(b.x)], 1u);
    return b;
}
__device__ __forceinline__ void xcd_barrier_complete(unsigned* bar, unsigned x, unsigned& nloc, unsigned& nx) {
    const unsigned G = gridDim.x * gridDim.y * gridDim.z;
    unsigned sum, cnt, mine, sp = 0u;
    for (;;) {
        sum = 0u; cnt = 0u; mine = 0u;
#pragma unroll
        for (unsigned j = 0; j < 16; ++j) { const unsigned c = xb_ld(&bar[XB_XCNT(j)]); sum += c; cnt += (c > 0u) ? 1u : 0u; mine = (j == x) ? c : mine; }
        if (sum == G) break;
        __builtin_amdgcn_s_sleep(1);
        if ((++sp & 255u) == 0u) { if (xb_ld(&bar[XB_TMO])) break; if (sp > XB_SPIN_CAP) { atomicAdd(&bar[XB_TMO], 1u); break; } }
    }
    nloc = mine > 0u ? mine : 1u; nx = cnt > 0u ? cnt : 1u;
}
__device__ __forceinline__ void xcd_barrier(const XcdBarrier& b) {
    asm volatile("s_waitcnt vmcnt(0)" ::: "memory");
    __syncthreads();
    if (threadIdx.x == 0) {
        unsigned* bar = b.bar;
        __builtin_amdgcn_s_waitcnt(0);
        unsigned nloc = b.st[0], nx = b.st[1];
        if (nloc == 0u) { xcd_barrier_complete(bar, b.x, nloc, nx); b.st[0] = nloc; b.st[1] = nx; }
        const unsigned old = xb_add(&bar[XB_XSUB(b.x)], 1u);
        const unsigned gen = old / nloc;
        if (old + 1u == (gen + 1u) * nloc) {
            __builtin_amdgcn_fence(__ATOMIC_RELEASE, "agent");
            asm volatile("s_waitcnt vmcnt(0)" ::: "memory");
            const unsigned og = xb_add(&bar[XB_TOP], 1u);
            const unsigned tg = og / nx;
            if (og + 1u == (tg + 1u) * nx) xb_add(&bar[XB_TOPGEN], 1u);
            else XB_SPIN(xb_ld(&bar[XB_TOPGEN]) == tg, bar);
            __builtin_amdgcn_fence(__ATOMIC_ACQUIRE, "agent");
            xb_add(&bar[XB_XGEN(b.x)], 1u);
            asm volatile("s_waitcnt vmcnt(0)" ::: "memory");
        } else {
            XB_SPIN(xb_ld(&bar[XB_XGEN(b.x)]) == gen, bar);
            __builtin_amdgcn_fence(__ATOMIC_ACQUIRE, "agent");
            asm volatile("s_waitcnt vmcnt(0)" ::: "memory");
        }
    }
    __syncthreads();
}
constexpr int MISC_OFF = 160 * 1024 - 64;
constexpr size_t CTL_ZERO_BYTES = 65536;

__global__ void __launch_bounds__(512) hymba_fwd(Params P) {
    extern __shared__ __attribute__((aligned(16))) unsigned char lds[];
    PG8_LAS unsigned char* lds3 = (PG8_LAS unsigned char*)lds;
    unsigned char* ws = P.ws;
    const int lo = P.ph_lo, hi = P.ph_hi;
    const int G = gridDim.x;
#define IN(k) (lo <= (k) && (k) < hi)
#define SEAM(k) do { if (IN(k) && IN((k) + 1)) { xcd_barrier(xbar); } } while (0)
    { volatile LAS unsigned* misc = (volatile LAS unsigned*)(lds3 + MISC_OFF); if (threadIdx.x < 16) misc[threadIdx.x] = 0u; }
    __syncthreads();
    if (hi > NPHASE + 1000) cg::this_grid().sync();
    XcdBarrier xbar = xcd_barrier_post((unsigned*)(ws + 16384), (volatile LAS unsigned*)(lds3 + MISC_OFF));
#define TIDX() int tid = threadIdx.x; asm volatile("" : "+v"(tid)); const int lane = tid & 63, wave = __builtin_amdgcn_readfirstlane(tid >> 6); const int gw = blockIdx.x * 8 + wave, NGW = G * 8; (void)lane; (void)gw; (void)NGW
    typedef pg8::bf16_t bt;
    if (IN(0)) { TIDX(); phase0(P, lds, gw, NGW, wave, lane); } SEAM(0);
    if (IN(1)) {
        pg8::Gemm g{(const bt*)(ws + WS_HN), (const bt*)(ws + WS_WIN), MP, INWP, 1024, 1024, 1024}; pg8::StaticOrder S; S.init(MP, INWP, G, (int)blockIdx.x);
        pg8::EpiInProj E{(bt*)(ws + WS_LAT), (bt*)(ws + WS_Z), (bt*)(ws + WS_XBC), (float*)(ws + WS_DT), P.dt_bias};
        pg8::gemm_phase<pg8::EpiInProj, pg8::StaticOrder, true, true>(lds3, g, S, E);
        { TIDX(); __syncthreads();
          const int nextra = S.nwg % G;
          if (nextra > 0 && nextra < G) { if ((int)blockIdx.x >= nextra) { const int hw = ((int)blockIdx.x - nextra) * 8 + wave, nhw = (G - nextra) * 8;
                  convert_weights(P, lds, hw, nhw, wave, lane, W_ITEMS_IN, W_ITEMS_ALL); build_rope(P, hw, nhw, lane); } }
          else { convert_weights(P, lds, gw, NGW, wave, lane, W_ITEMS_IN, W_ITEMS_ALL); build_rope(P, gw, NGW, lane); } }
    } SEAM(1);
    if (IN(2)) { TIDX(); phase_ssd_states(P, lds, tid, wave, lane); } SEAM(2);
    if (IN(3)) { TIDX(); if (wave < 4) phase_scan(P, tid); else phase_latn(P, (int)blockIdx.x * 4 + (wave - 4), G * 4, lane); } SEAM(3);
    if (IN(4)) { TIDX(); phase_ssd_y(P, lds, tid, wave, lane); } SEAM(4);
    if (IN(5)) {
        { pg8::Gemm g{(const bt*)(ws + WS_LAT), (const bt*)(ws + WS_WQ), MP, QW, 384, LATW, 384}; pg8::StaticOrder S; S.init(MP, QW, G, (int)blockIdx.x);
          pg8::EpiBf16<0> E{(bt*)(ws + WS_Q), QW, QSCALE}; pg8::gemm_phase<pg8::EpiBf16<0>, pg8::StaticOrder, true, true>(lds3, g, S, E); }
        __syncthreads();
        { pg8::Gemm g{(const bt*)(ws + WS_LAT) + 384, (const bt*)(ws + WS_WK), MP, 1024, 256, LATW, 256}; pg8::StaticOrder S; S.init(MP, 1024, G, (int)((blockIdx.x + 120u) % (unsigned)G));
          pg8::EpiBf16<0> E{(bt*)(ws + WS_K), 1024, 1.f}; pg8::gemm_phase<pg8::EpiBf16<0>, pg8::StaticOrder, true, true>(lds3, g, S, E); }
        __syncthreads();
        { pg8::Gemm g{(const bt*)(ws + WS_WV), (const bt*)(ws + WS_LAT) + 384, 1024, MP, 256, 256, LATW}; pg8::StaticOrder S; S.init(1024, MP, G, (int)((blockIdx.x + 112u) % (unsigned)G));
          pg8::EpiBf16<0> E{(bt*)(ws + WS_VT), MP, 1.f}; pg8::gemm_phase<pg8::EpiBf16<0>, pg8::StaticOrder, true, true>(lds3, g, S, E); }
    } SEAM(5);
    if (IN(6)) { TIDX();
        if (wave >= 4) __builtin_amdgcn_s_setprio(1);
        att::phase(P, lds, tid, wave, lane);
        if (wave >= 4) __builtin_amdgcn_s_setprio(0);
    } SEAM(6);
    if (IN(7)) {
        pg8::Gemm g{(const bt*)(ws + WS_MIX) + (size_t)NMETA * 2048, (const bt*)(ws + WS_WOUT), SEQ, 1024, 2048, 2048, 2048}; pg8::StaticOrder S; S.init(SEQ, 1024, G, (int)blockIdx.x);
        pg8::EpiBf16<0> E{(bt*)(ws + WS_MIXO), 1024, 1.f}; pg8::gemm_phase<pg8::EpiBf16<0>, pg8::StaticOrder, false, true>(lds3, g, S, E);
    } SEAM(7);
    if (IN(8)) { TIDX(); phase_rows1(P, gw, NGW, lane); } SEAM(8);
    if (IN(9)) {
        pg8::Gemm g{(const bt*)(ws + WS_HN2), (const bt*)(ws + WS_WUP), SEQ, DFF, 1024, 1024, 1024}; pg8::StaticOrder S; S.init(SEQ, DFF, G, (int)blockIdx.x);
        pg8::EpiBf16<2> E{(bt*)(ws + WS_FF), DFF, 1.f}; pg8::gemm_phase<pg8::EpiBf16<2>, pg8::StaticOrder, true, true>(lds3, g, S, E);
    } SEAM(9);
    if (IN(10)) {
        pg8::Gemm g{(const bt*)(ws + WS_FF), (const bt*)(ws + WS_WDN), SEQ, 1024, DFF, DFF, DFF}; pg8::StaticOrder S; S.init(SEQ, 1024, G, (int)blockIdx.x);
        pg8::EpiBf16<0> E{(bt*)(ws + WS_F), 1024, 1.f}; pg8::gemm_phase<pg8::EpiBf16<0>, pg8::StaticOrder, false, true>(lds3, g, S, E);
    } SEAM(10);
    if (IN(11)) { TIDX(); phase_rows2(P, gw, NGW, lane); }
#undef IN
#undef SEAM
#undef TIDX
}

extern "C" void kernel_launch(void* const* d_in, const int* in_sizes, int n_in, void* d_out, int out_size, void* d_ws, size_t ws_size, hipStream_t stream) {
    static int grid = 0;
    if (grid == 0) {
        int dev = 0, cus = 0, per_cu = 0;
        (void)hipGetDevice(&dev); (void)hipDeviceGetAttribute(&cus, hipDeviceAttributeMultiprocessorCount, dev);
        if (hipFuncSetAttribute((const void*)hymba_fwd, hipFuncAttributeMaxDynamicSharedMemorySize, LDS_BYTES) != hipSuccess) { fprintf(stderr, "hipFuncSetAttribute failed\n"); }
        if (hipOccupancyMaxActiveBlocksPerMultiprocessor(&per_cu, (const void*)hymba_fwd, 512, LDS_BYTES) != hipSuccess || per_cu < 1) { fprintf(stderr, "occupancy query: %d\n", per_cu); per_cu = 1; }
        (void)hipGetLastError();
        grid = cus * 1;
        if (ws_size < 256 * MiB) { fprintf(stderr, "workspace too small: %zu\n", ws_size); grid = -1; }
    }
    if (grid < 0) return;
    Params p{};
    const float** pp = (const float**)&p;
    for (int i = 0; i < 20; ++i) pp[i] = (const float*)d_in[i];
    p.out = (float*)d_out; p.ws = (unsigned char*)d_ws;
    for (int j = 0; j < 32; ++j) p.invf[j] = (float)pow(10000.0, -(double)(2 * j) / 64.0);
#if ONE_LAUNCH
    p.ph_lo = 0; p.ph_hi = NPHASE;
    if (hipMemsetAsync(d_ws, 0, CTL_ZERO_BYTES, stream) != hipSuccess) { fprintf(stderr, "memset of the barrier words failed\n"); return; }
    void* args[] = {&p};
    hipError_t e = hipLaunchCooperativeKernel((const void*)hymba_fwd, dim3(grid), dim3(512), args, LDS_BYTES, stream);
    if (e != hipSuccess) fprintf(stderr, "cooperative launch failed: %s (grid %d)\n", hipGetErrorString(e), grid);
#else
    for (int ph = 0; ph < NPHASE; ++ph) { p.ph_lo = ph; p.ph_hi = ph + 1; hipLaunchKernelGGL(hymba_fwd, dim3(grid), dim3(512), LDS_BYTES, stream, p); }
#endif
}
```
